# Optimizing an MI355X kernel written in HIP

```python
import math
import jax, jax.numpy as jnp
from jax import lax
import numpy as np

D_MODEL = 1024
BATCH = 32
SEQ = 2048
DEPTH = 4

N_A_LAYERS = max(1, DEPTH // 2)
N_B_LAYERS = DEPTH - N_A_LAYERS
POOL_WINDOWS = (2, 4, 8, 16)
N_POOL_GROUPS = len(POOL_WINDOWS)
POOL_GROUP_DIM = D_MODEL // N_POOL_GROUPS
HEAD_DIM = 64
N_HEADS = D_MODEL // HEAD_DIM
DILATED_GROUPS = ((128, 1), (512, 4), (2048, 16))
N_GROUPS = len(DILATED_GROUPS)
ATTN_DIM = N_HEADS * HEAD_DIM
Q_DIM = N_GROUPS * ATTN_DIM
ROPE_THETA = 10000.0
D_FF = 2816
CONV_WIDTH = 3
DEEPNORM_ALPHA = (2.0 * DEPTH) ** 0.25
DEEPNORM_BETA = (8.0 * DEPTH) ** -0.25
LN_EPS = 1e-5

kernel_name = "yoco_pool_dilated_attn_convffn_deepnorm"


def layer_norm(x, g, b):
    xf = x.astype(jnp.float32)
    mu = xf.mean(-1, keepdims=True)
    var = jnp.square(xf - mu).mean(-1, keepdims=True)
    y = (xf - mu) * lax.rsqrt(var + LN_EPS) * g.astype(jnp.float32) + b.astype(jnp.float32)
    return y.astype(x.dtype)


def rope_tables(seq):
    inv_freq = ROPE_THETA ** (-jnp.arange(0, HEAD_DIM, 2, dtype=jnp.float32) / HEAD_DIM)
    ang = jnp.arange(seq, dtype=jnp.float32)[:, None] * inv_freq[None, :]
    return jnp.cos(ang), jnp.sin(ang)


def apply_rope(t, cos, sin):
    tf = t.astype(jnp.float32)
    x1, x2 = tf[..., : HEAD_DIM // 2], tf[..., HEAD_DIM // 2:]
    c, s = cos[None, :, None, :], sin[None, :, None, :]
    return jnp.concatenate([x1 * c - x2 * s, x2 * c + x1 * s], axis=-1).astype(t.dtype)


def pool_mixer(x, pool_w, pool_scale):
    B, S, D = x.shape
    xg = x.reshape(B, S, N_POOL_GROUPS, POOL_GROUP_DIM)
    csum = jnp.cumsum(xg.astype(jnp.float32), axis=1)
    c0 = jnp.concatenate([jnp.zeros_like(csum[:, :1]), csum], axis=1)
    pos = jnp.arange(S, dtype=jnp.float32)
    pooled = []
    for g, w in enumerate(POOL_WINDOWS):
        w_eff = min(w, S)
        lagged = jnp.concatenate([jnp.zeros_like(c0[:, : w_eff - 1, g]), c0[:, : S - w_eff + 1, g]], axis=1)
        count = jnp.minimum(pos + 1.0, float(w))[None, :, None]
        pooled.append((c0[:, 1:, g] - lagged) / count)
    pooled = jnp.stack(pooled, axis=2).astype(x.dtype) - xg
    y = jnp.einsum('bsgc,gce->bsge', pooled, pool_w).reshape(B, S, D)
    return y * pool_scale


def dilated_branch(q, k, v, dilation, span):
    B, S, H, Dh = q.shape
    L = S // dilation
    nb = -(-L // span)
    pad = nb * span - L

    def strided_blocks(t):
        t = t.reshape(B, L, dilation, H, Dh).transpose(0, 2, 3, 1, 4)
        t = jnp.pad(t, ((0, 0), (0, 0), (0, 0), (0, pad), (0, 0)))
        return t.reshape(B, dilation, H, nb, span, Dh)

    def with_prev(t):
        prev = jnp.concatenate([jnp.zeros_like(t[:, :, :, :1]), t[:, :, :, :-1]], axis=3)
        return jnp.concatenate([prev, t], axis=4)

    qb = strided_blocks(q)
    kk = with_prev(strided_blocks(k))
    vv = with_prev(strided_blocks(v))
    s = jnp.einsum('brhnqc,brhnkc->brhnqk', qb, kk, preferred_element_type=jnp.float32)
    qi = jnp.arange(span)[:, None]
    kj = jnp.arange(2 * span)[None, :]
    rel = span + qi - kj
    band = (rel >= 0) & (rel <= span)
    has_prev = (jnp.arange(nb) > 0)[:, None, None] | (kj >= span)[None]
    valid = band[None] & has_prev
    s = jnp.where(valid, s, -jnp.inf)
    m = s.max(-1, keepdims=True)
    p = jnp.exp(s - m)
    l = p.sum(-1, keepdims=True)
    o = jnp.einsum('brhnqk,brhnkc->brhnqc', (p / l).astype(v.dtype), vv)
    lse = (m + jnp.log(l))[..., 0]
    o = o.reshape(B, dilation, H, nb * span, Dh)[:, :, :, :L].transpose(0, 3, 1, 2, 4).reshape(B, S, H, Dh)
    lse = lse.reshape(B, dilation, H, nb * span)[..., :L].transpose(0, 3, 1, 2).reshape(B, S, H)
    return o, lse


def dilated_attention(x, k_shared, v_shared, w_q, w_o, cos, sin):
    B, S, _ = x.shape
    q = (x @ w_q).reshape(B, S, N_GROUPS * N_HEADS, HEAD_DIM)
    q = (apply_rope(q, cos, sin) * (HEAD_DIM ** -0.5)).reshape(B, S, N_GROUPS, N_HEADS, HEAD_DIM)
    outs, lses = [], []
    for g, (window, dilation) in enumerate(DILATED_GROUPS):
        o, lse = dilated_branch(q[:, :, g], k_shared[:, :, g], v_shared[:, :, g], dilation, window // dilation)
        outs.append(o)
        lses.append(lse)
    weights = jax.nn.softmax(jnp.stack(lses, axis=0), axis=0)
    o = jnp.sum(weights[..., None].astype(x.dtype) * jnp.stack(outs, axis=0), axis=0)
    return o.reshape(B, S, ATTN_DIM) @ w_o


def conv_ffn(x, w_gate, w_up, conv_w, conv_b, w_down):
    S = x.shape[1]
    g = x @ w_gate
    u = x @ w_up
    gp = jnp.pad(g, ((0, 0), (CONV_WIDTH - 1, 0), (0, 0)))
    conv = conv_b
    for j in range(CONV_WIDTH):
        conv = conv + conv_w[j] * gp[:, j: j + S]
    h = jax.nn.gelu(conv) * u
    return h @ w_down


def setup_inputs(seed: int = 0) -> dict:
    key = jax.random.key(seed)
    ks = jax.random.split(key, 16)
    f32 = jnp.float32
    beta = DEEPNORM_BETA
    nrm = lambda k, shape, scale: jax.random.normal(k, shape, f32) * scale
    x = jax.random.normal(ks[0], (BATCH, SEQ, D_MODEL), f32)
    pool_w = nrm(ks[1], (N_A_LAYERS, N_POOL_GROUPS, POOL_GROUP_DIM, POOL_GROUP_DIM), beta * POOL_GROUP_DIM ** -0.5)
    pool_scale = 1.0 + nrm(ks[2], (N_A_LAYERS, D_MODEL), 0.1)
    w_q = nrm(ks[3], (N_B_LAYERS, D_MODEL, Q_DIM), D_MODEL ** -0.5)
    w_k = nrm(ks[4], (D_MODEL, Q_DIM), D_MODEL ** -0.5)
    w_v = nrm(ks[5], (D_MODEL, Q_DIM), beta * D_MODEL ** -0.5)
    w_kv = jnp.concatenate([w_k, w_v], axis=1)
    w_o = nrm(ks[6], (N_B_LAYERS, ATTN_DIM, D_MODEL), beta * ATTN_DIM ** -0.5)
    ffn_w_gate = nrm(ks[7], (DEPTH, D_MODEL, D_FF), D_MODEL ** -0.5)
    ffn_w_up = nrm(ks[8], (DEPTH, D_MODEL, D_FF), beta * D_MODEL ** -0.5)
    ffn_conv_w = nrm(ks[9], (DEPTH, CONV_WIDTH, D_FF), CONV_WIDTH ** -0.5)
    ffn_conv_b = nrm(ks[10], (DEPTH, D_FF), 0.02)
    ffn_w_down = nrm(ks[11], (DEPTH, D_FF, D_MODEL), beta * D_FF ** -0.5)
    ln1_g = 1.0 + nrm(ks[12], (DEPTH, D_MODEL), 0.05)
    ln1_b = nrm(ks[13], (DEPTH, D_MODEL), 0.02)
    ln2_g = 1.0 + nrm(ks[14], (DEPTH, D_MODEL), 0.05)
    ln2_b = nrm(ks[15], (DEPTH, D_MODEL), 0.02)
    return {"x": x, "pool_w": pool_w, "pool_scale": pool_scale, "w_q": w_q, "w_kv": w_kv,
            "w_o": w_o, "ffn_w_gate": ffn_w_gate, "ffn_w_up": ffn_w_up, "ffn_conv_w": ffn_conv_w,
            "ffn_conv_b": ffn_conv_b, "ffn_w_down": ffn_w_down, "ln1_g": ln1_g, "ln1_b": ln1_b,
            "ln2_g": ln2_g, "ln2_b": ln2_b}


def reference(x, pool_w, pool_scale, w_q, w_kv, w_o, ffn_w_gate, ffn_w_up, ffn_conv_w,
              ffn_conv_b, ffn_w_down, ln1_g, ln1_b, ln2_g, ln2_b):
    B, S, _ = x.shape
    cos, sin = rope_tables(S)
    k_shared = None
    v_shared = None
    for i in range(DEPTH):
        if i < N_A_LAYERS:
            mix = pool_mixer(x, pool_w[i], pool_scale[i])
        else:
            j = i - N_A_LAYERS
            mix = dilated_attention(x, k_shared, v_shared, w_q[j], w_o[j], cos, sin)
        x = layer_norm(DEEPNORM_ALPHA * x + mix, ln1_g[i], ln1_b[i])
        ffn = conv_ffn(x, ffn_w_gate[i], ffn_w_up[i], ffn_conv_w[i], ffn_conv_b[i], ffn_w_down[i])
        x = layer_norm(DEEPNORM_ALPHA * x + ffn, ln2_g[i], ln2_b[i])
        if i == N_A_LAYERS - 1:
            kv = (x @ w_kv).reshape(B, S, 2, N_GROUPS * N_HEADS, HEAD_DIM)
            k_shared = apply_rope(kv[:, :, 0], cos, sin).reshape(B, S, N_GROUPS, N_HEADS, HEAD_DIM)
            v_shared = kv[:, :, 1].reshape(B, S, N_GROUPS, N_HEADS, HEAD_DIM)
    return x
```

```cpp
#include <hip/hip_runtime.h>
#include <hip/hip_cooperative_groups.h>
#include <cstdio>
#include <cstdint>
#include <cmath>
namespace cg = cooperative_groups;
namespace pg8 {
#define PG8_LAS __attribute__((address_space(3)))
typedef unsigned short bf16_t;
typedef short bf16x8 __attribute__((ext_vector_type(8)));
typedef float f32x4 __attribute__((ext_vector_type(4)));
typedef unsigned u32x4 __attribute__((ext_vector_type(4)));
constexpr int BM = 256, BK = 64, HALF = 128, HTB = HALF * BK * 2  , STAGE_BYTES = 8 * HTB, NXCD = 8, WGM = 8;

__host__ __device__ __forceinline__ int lds_byte(int r, int c) { const int st = (r >> 4) * 2 + (c >> 5), rr = r & 15, cc = c & 31, ob = rr * 64 + cc * 2; return st * 1024 + (ob ^ (((ob >> 9) & 1) << 5)); }
__host__ __device__ __forceinline__ void stage_rc(int b, int& R, int& C) { const int st = b / 1024, sb = b % 1024, swz = sb ^ (((sb >> 9) & 1) << 5); R = (st >> 1) * 16 + swz / 64; C = (st & 1) * 32 + (swz % 64) / 2; }
__host__ __device__ __forceinline__ int perm32(int rho) { const int n = rho >> 4, i = rho & 15; return 8 * (i >> 2) + 4 * n + (i & 3); }

struct Unit { int pm, pn; };
struct Gemm { const bf16_t* A; const bf16_t* Bt; int M, N, K; };

struct StaticOrder {
    int nM, nN, nwg, G, c;
    __host__ __device__ void init(int M, int N, int G_, int c_) { nM = M / BM; nN = N / BM; nwg = nM * nN; G = G_; c = c_; }
    __host__ __device__ bool next(int i, Unit& u) const {
        const long L = (long)i * G + c; if (L >= nwg) return false;
        int wgid = (int)L; { const int q = nwg / NXCD, r = nwg % NXCD, xcd = wgid % NXCD, off = wgid / NXCD; wgid = (xcd < r ? xcd * (q + 1) : r * (q + 1) + (xcd - r) * q) + off; }
        const int nig = WGM * nN, gid = wgid / nig, fm = gid * WGM, gsz = (nM - fm) < WGM ? (nM - fm) : WGM;
        u.pm = fm + ((wgid % nig) % gsz); u.pn = (wgid % nig) / gsz; return true;
    }
    __device__ __forceinline__ void a_ready(const Unit&) const {}
    __device__ __forceinline__ void done(const Unit&) const {}
};

__device__ __forceinline__ unsigned cvt_pk_bf16(float lo, float hi) { unsigned r; asm volatile("v_cvt_pk_bf16_f32 %0, %1, %2" : "=v"(r) : "v"(lo), "v"(hi)); return r; }
template <class Epi, class Sched, bool ALIGN_EPI = false, bool SP2 = false>
__device__ __forceinline__ void gemm_phase(PG8_LAS unsigned char* lds, const Gemm g, const Sched& S, const Epi& E, int tid_in) {
    int tid_ = tid_in; asm volatile("" : "+v"(tid_)); const int tid = tid_, wid = __builtin_amdgcn_readfirstlane(tid >> 6), lane = tid & 63, wr = wid >> 2, wc = wid & 3, fr = lane & 15, fq = lane >> 4;
    const int K = g.K, nt = K / BK;
    unsigned voffA[2], voffB[2];
#pragma unroll
    for (int i = 0; i < 2; ++i) { int R, C; stage_rc(tid * 16 + i * 8192, R, C); const int Rb = Epi::bmap(Epi::PERM ? ((R & ~31) + perm32(R & 31)) : R);
        voffA[i] = (unsigned)(Epi::amap(R) * K + C) * 2u; voffB[i] = (unsigned)(Rb * K + C) * 2u; }
    const size_t kstep = (size_t)(BK * 2);
    const size_t hstep = (size_t)HALF * K * 2;
    const size_t tstep = 2 * hstep;
    const unsigned ldsw = (unsigned)wid * 1024u;
    const int aoff = lds_byte(wr * 64 + fr, fq * 8), boff = lds_byte(wc * 32 + fr, fq * 8);
#define PG8_SA(b, h) (((b) * 2 + (h)) * HTB)
#define PG8_SB(b, h) ((4 + (b) * 2 + (h)) * HTB)
#define PG8_STAGE(bufoff, gbase, voff) do { _Pragma("unroll") for (int _i = 0; _i < 2; ++_i) \
        __builtin_amdgcn_global_load_lds((const unsigned*)((const char*)(gbase) + (voff)[_i]), (PG8_LAS unsigned*)(lds + (bufoff) + ldsw + _i * 8192), 16, 0, 0); } while (0)
#define PG8_LDA(dst, b, h) do { _Pragma("unroll") for (int m = 0; m < 4; ++m) _Pragma("unroll") for (int k = 0; k < 2; ++k) dst[m][k] = *(const PG8_LAS bf16x8*)(lds + PG8_SA(b, h) + aoff + m * 2048 + k * 1024); } while (0)
#define PG8_LDB(dst, b, h) do { _Pragma("unroll") for (int n = 0; n < 2; ++n) _Pragma("unroll") for (int k = 0; k < 2; ++k) dst[n][k] = *(const PG8_LAS bf16x8*)(lds + PG8_SB(b, h) + boff + n * 2048 + k * 1024); } while (0)
#define PG8_MMA(ai, bj, At, Bt) do { __builtin_amdgcn_s_setprio(1); _Pragma("unroll") for (int m = 0; m < 4; ++m) _Pragma("unroll") for (int n = 0; n < 2; ++n) _Pragma("unroll") for (int k = 0; k < 2; ++k) \
        acc[ai][bj][m][n] = __builtin_amdgcn_mfma_f32_16x16x32_bf16(Bt[n][k], At[m][k], acc[ai][bj][m][n], 0, 0, 0); __builtin_amdgcn_s_setprio(0); } while (0)
#define PG8_WAIT_V(n) asm volatile("s_waitcnt vmcnt(" #n ")" ::: "memory")
#define PG8_WAIT_L(n) asm volatile("s_waitcnt lgkmcnt(" #n ")" ::: "memory")
#define PG8_BAR __builtin_amdgcn_s_barrier()
#define PG8_SCHED __builtin_amdgcn_sched_barrier(0)
    Unit cur, nxt; int ui = 0;
    if (!S.next(0, cur)) return;
    f32x4 acc[2][2][4][2];
#pragma unroll
    for (int a = 0; a < 2; ++a)
#pragma unroll
        for (int b = 0; b < 2; ++b)
#pragma unroll
            for (int m = 0; m < 4; ++m)
#pragma unroll
                for (int n = 0; n < 2; ++n) acc[a][b][m][n] = (f32x4){0.f, 0.f, 0.f, 0.f};
    bf16x8 At[4][2], B0[2][2], B1[2][2];
    const char* cA = (const char*)g.A + (size_t)cur.pm * tstep; const char* cB = (const char*)g.Bt + (size_t)cur.pn * tstep;
    S.a_ready(cur);
    if constexpr (SP2) {
        PG8_STAGE(PG8_SB(0, 0), cB, voffB); PG8_STAGE(PG8_SB(0, 1), cB + hstep, voffB); PG8_STAGE(PG8_SA(0, 0), cA, voffA); PG8_STAGE(PG8_SA(0, 1), cA + hstep, voffA);
        if (wr == 1) PG8_BAR;
        PG8_WAIT_V(2); PG8_BAR;
        PG8_STAGE(PG8_SB(1, 0), cB + kstep, voffB); PG8_STAGE(PG8_SA(1, 0), cA + kstep, voffA); PG8_STAGE(PG8_SB(1, 1), cB + hstep + kstep, voffB);
        PG8_WAIT_V(6); PG8_BAR;
    } else {
        PG8_STAGE(PG8_SB(0, 0), cB, voffB); PG8_STAGE(PG8_SA(0, 0), cA, voffA); PG8_STAGE(PG8_SB(0, 1), cB + hstep, voffB); PG8_STAGE(PG8_SA(0, 1), cA + hstep, voffA);
        if (wr == 1) PG8_BAR;
        PG8_WAIT_V(4); PG8_BAR;
        PG8_STAGE(PG8_SB(1, 0), cB + kstep, voffB); PG8_STAGE(PG8_SA(1, 0), cA + kstep, voffA); PG8_STAGE(PG8_SB(1, 1), cB + hstep + kstep, voffB);
        PG8_WAIT_V(6); PG8_BAR;
    }
    for (;;) {
        const bool has_next = S.next(ui + 1, nxt);
        const char* nA = has_next ? (const char*)g.A + (size_t)nxt.pm * tstep : cA; const char* nB = has_next ? (const char*)g.Bt + (size_t)nxt.pn * tstep : cB;
        for (int t = 0; t < nt; t += 2) {
            const bool last = (t == nt - 2);
            const char* a1 = cA + (size_t)(t + 1) * kstep;
            const char* a2 = last ? nA : cA + (size_t)(t + 2) * kstep; const char* b2 = last ? nB : cB + (size_t)(t + 2) * kstep;
            const char* a3 = a2 + kstep; const char* b3 = b2 + kstep;
            if (last && has_next) S.a_ready(nxt);
            if constexpr (SP2) {
            PG8_LDB(B0, 0, 0); PG8_LDB(B1, 0, 1); PG8_SCHED; PG8_LDA(At, 0, 0); PG8_STAGE(PG8_SA(1, 1), a1 + hstep, voffA);
            PG8_WAIT_V(8); PG8_WAIT_L(0); PG8_BAR; PG8_MMA(0, 0, At, B0); PG8_MMA(0, 1, At, B1); PG8_BAR; PG8_SCHED;
            PG8_LDA(At, 0, 1); PG8_STAGE(PG8_SB(0, 0), b2, voffB); PG8_STAGE(PG8_SB(0, 1), b2 + hstep, voffB); PG8_STAGE(PG8_SA(0, 0), a2, voffA);
            PG8_WAIT_V(8); PG8_WAIT_L(0); PG8_BAR; PG8_MMA(1, 0, At, B0); PG8_MMA(1, 1, At, B1); PG8_BAR; PG8_SCHED;
            PG8_LDB(B0, 1, 0); PG8_LDB(B1, 1, 1); PG8_SCHED; PG8_LDA(At, 1, 0); PG8_STAGE(PG8_SA(0, 1), a2 + hstep, voffA);
            PG8_WAIT_V(8); PG8_WAIT_L(0); PG8_BAR; PG8_MMA(0, 0, At, B0); PG8_MMA(0, 1, At, B1); PG8_BAR; PG8_SCHED;
            PG8_LDA(At, 1, 1); PG8_STAGE(PG8_SB(1, 0), b3, voffB); PG8_STAGE(PG8_SB(1, 1), b3 + hstep, voffB); PG8_STAGE(PG8_SA(1, 0), a3, voffA);
            PG8_WAIT_V(8); PG8_WAIT_L(0); PG8_BAR; PG8_MMA(1, 0, At, B0); PG8_MMA(1, 1, At, B1); PG8_BAR; PG8_SCHED;
            } else {
            PG8_LDB(B0, 0, 0); PG8_SCHED; PG8_LDA(At, 0, 0); PG8_STAGE(PG8_SA(1, 1), a1 + hstep, voffA);
            PG8_WAIT_L(8); PG8_BAR; PG8_WAIT_L(0); PG8_MMA(0, 0, At, B0); PG8_BAR; PG8_SCHED;
            PG8_LDB(B1, 0, 1); PG8_STAGE(PG8_SB(0, 0), b2, voffB);
            PG8_BAR; PG8_WAIT_L(0); PG8_MMA(0, 1, At, B1); PG8_BAR;
            PG8_LDA(At, 0, 1); PG8_STAGE(PG8_SA(0, 0), a2, voffA);
            PG8_BAR; PG8_WAIT_L(0); PG8_MMA(1, 0, At, B0); PG8_BAR; PG8_SCHED;
            PG8_STAGE(PG8_SB(0, 1), b2 + hstep, voffB);
            PG8_WAIT_V(6); PG8_BAR; PG8_MMA(1, 1, At, B1); PG8_BAR;
            PG8_LDB(B0, 1, 0); PG8_SCHED; PG8_LDA(At, 1, 0); PG8_STAGE(PG8_SA(0, 1), a2 + hstep, voffA);
            PG8_WAIT_L(8); PG8_BAR; PG8_WAIT_L(0); PG8_MMA(0, 0, At, B0); PG8_BAR; PG8_SCHED;
            PG8_LDB(B1, 1, 1); PG8_STAGE(PG8_SB(1, 0), b3, voffB);
            PG8_BAR; PG8_WAIT_L(0); PG8_MMA(0, 1, At, B1); PG8_BAR;
            PG8_LDA(At, 1, 1); PG8_STAGE(PG8_SA(1, 0), a3, voffA);
            PG8_BAR; PG8_WAIT_L(0); PG8_MMA(1, 0, At, B0); PG8_BAR; PG8_SCHED;
            PG8_STAGE(PG8_SB(1, 1), b3 + hstep, voffB);
            PG8_WAIT_V(6); PG8_BAR; PG8_MMA(1, 1, At, B1); PG8_BAR;
            }
        }
        if constexpr (ALIGN_EPI) { if (wr == 0) PG8_BAR; }
        if constexpr (!Epi::AFTER_DRAIN) { E(acc, cur, wr, wc, fr, fq); S.done(cur); }
        if (!has_next) break;
#pragma unroll
        for (int a = 0; a < 2; ++a)
#pragma unroll
            for (int b = 0; b < 2; ++b)
#pragma unroll
                for (int m = 0; m < 4; ++m)
#pragma unroll
                    for (int n = 0; n < 2; ++n) acc[a][b][m][n] = (f32x4){0.f, 0.f, 0.f, 0.f};
        cur = nxt; cA = nA; cB = nB; ++ui;
        if constexpr (ALIGN_EPI) { if (wr == 1) PG8_BAR; }
    }
    PG8_WAIT_V(0);
    if constexpr (!ALIGN_EPI) { if (wr == 0) PG8_BAR; }
    PG8_BAR;
    if constexpr (Epi::AFTER_DRAIN) { E.fused(acc, cur, wr, wc, fr, fq, lds, wid, lane); S.done(cur); }
#undef PG8_SA
#undef PG8_SB
#undef PG8_STAGE
#undef PG8_LDA
#undef PG8_LDB
#undef PG8_MMA
#undef PG8_WAIT_V
#undef PG8_WAIT_L
#undef PG8_BAR
#undef PG8_SCHED
}
}

#define LAS __attribute__((address_space(3)))
typedef unsigned short bf16;
typedef float f32x4 __attribute__((ext_vector_type(4)));
typedef float f32x16 __attribute__((ext_vector_type(16)));
typedef short bf16x8 __attribute__((ext_vector_type(8)));
typedef unsigned u32x4 __attribute__((ext_vector_type(4)));
typedef unsigned u32x2 __attribute__((ext_vector_type(2)));
typedef __bf16 bf16x2_t __attribute__((ext_vector_type(2)));
typedef float f32x2_t __attribute__((ext_vector_type(2)));

constexpr int DM = 1024, SEQ = 2048, MTOK = 65536, DFF = 2816, QD = 3072;
constexpr int MH = 32768;
constexpr float ALPHA = 1.6817928305074290f;
constexpr float LN_EPS = 1e-5f;
constexpr float QSCALE = 0.125f * 1.4426950408889634f;
constexpr int NTHREADS = 512, NWAVES = 8;
constexpr int LDS_BYTES = 131072 + 1024;

constexpr size_t MiB = 1u << 20;
constexpr size_t WS_WPOOL = 0;
constexpr size_t WS_WGU = 1 * MiB;
constexpr size_t WS_WDOWN = 45 * MiB;
constexpr size_t WS_WQ = 67 * MiB;
constexpr size_t WS_WK = 79 * MiB;
constexpr size_t WS_WV = 85 * MiB;
constexpr size_t WS_WO = 91 * MiB;
constexpr size_t WS_ROPE = 95 * MiB;
constexpr size_t WS_BAR = 95 * MiB + 768 * 1024;
constexpr size_t WS_XB = 96 * MiB;
constexpr size_t WS_GS = 224 * MiB;
constexpr size_t WS_US = 268 * MiB;
constexpr size_t WS_LSE = 290 * MiB;
constexpr size_t WS_ATT = 296 * MiB;
constexpr size_t WS_H = 360 * MiB;
constexpr size_t WS_K = 552 * MiB;
constexpr size_t WS_V = 744 * MiB;
constexpr size_t WS_FA = 712 * MiB;
constexpr size_t WS_STATS = 936 * MiB;
constexpr size_t WS_END = 937 * MiB;

struct Params {
    const float* x; const float* pool_w; const float* pool_scale; const float* w_q; const float* w_kv; const float* w_o;
    const float* w_gate; const float* w_up; const float* conv_w; const float* conv_b; const float* w_down;
    const float* ln1_g; const float* ln1_b; const float* ln2_g; const float* ln2_b;
    float* out; unsigned char* ws;
    double inv_freq[32];
    int ph_lo, ph_hi;
};

__device__ __forceinline__ unsigned pk2(float lo, float hi) { f32x2_t v = {lo, hi}; bf16x2_t b = __builtin_convertvector(v, bf16x2_t); return __builtin_bit_cast(unsigned, b); }
__device__ __forceinline__ float bflo(unsigned w) { return __builtin_bit_cast(float, w << 16); }
__device__ __forceinline__ float bfhi(unsigned w) { return __builtin_bit_cast(float, w & 0xffff0000u); }
__device__ __forceinline__ float shfl_xor_l(float v, int mask, int lane) { return __builtin_bit_cast(float, __builtin_amdgcn_ds_bpermute((lane ^ mask) << 2, __builtin_bit_cast(int, v))); }
__device__ __forceinline__ float wave_sum(float v, int lane) {
#pragma unroll
    for (int o = 1; o < 64; o <<= 1) v += shfl_xor_l(v, o, lane);
    return v;
}
__device__ __forceinline__ float gelu_tanh(float x) {
    const float e = __builtin_amdgcn_exp2f(x * (-2.3022081985f + -0.1029432392f * x * x));
    return x * __builtin_amdgcn_rcpf(1.0f + e);
}

using pg8::Unit;
struct EpiF {
    static constexpr bool PERM = true, AFTER_DRAIN = false; static constexpr int REPS = 1;
    static __host__ __device__ __forceinline__ int bmap(int r) { return r; }
    static __host__ __device__ __forceinline__ int amap(int r) { return r; }
    bf16* F; const float* scale; bool pool;
    __device__ __forceinline__ void operator()(const f32x4 (&acc)[2][2][4][2], const Unit& u, int wr, int wc, int fr, int fq) const {
        int fr_ = fr, fq_ = fq; asm volatile("" : "+v"(fr_), "+v"(fq_));
        const int row0 = (pool ? (u.pm >> 2) : u.pm) * 256 + wr * 64 + fr_, col0 = u.pn * 256 + wc * 32 + 8 * fq_;
#pragma unroll
        for (int bj = 0; bj < 2; ++bj) {
            f32x4 s0 = {1.f, 1.f, 1.f, 1.f}, s1 = {1.f, 1.f, 1.f, 1.f};
            if (scale) { s0 = *(const f32x4*)(scale + col0 + bj * 128); s1 = *(const f32x4*)(scale + col0 + bj * 128 + 4); }
#pragma unroll
            for (int ai = 0; ai < 2; ++ai)
#pragma unroll
                for (int m = 0; m < 4; ++m) {
                    const f32x4 v0 = acc[ai][bj][m][0] * s0, v1 = acc[ai][bj][m][1] * s1;
                    u32x4 w; w.x = pk2(v0[0], v0[1]); w.y = pk2(v0[2], v0[3]); w.z = pk2(v1[0], v1[1]); w.w = pk2(v1[2], v1[3]);
                    *(u32x4*)(F + (size_t)(row0 + ai * 128 + m * 16) * DM + col0 + bj * 128) = w;
                }
        }
    }
};
struct EpiGU {
    static constexpr bool PERM = true, AFTER_DRAIN = false; static constexpr int REPS = 1;
    static __host__ __device__ __forceinline__ int bmap(int r) { return r; }
    static __host__ __device__ __forceinline__ int amap(int r) { return (r & 64) + 4 * (r & 15) + ((r >> 4) & 3); }
    bf16* H; float* GS; float* US; const float* cw; const float* cb;
    __device__ __forceinline__ void operator()(const f32x4 (&acc)[2][2][4][2], const Unit& u, int wr, int wc, int fr, int fq) const {
        const int colbase = u.pn * 128 + wc * 32 + fq * 8;
        f32x4 cwv[2][4];
#pragma unroll
        for (int n = 0; n < 2; ++n) { const int col = colbase + 4 * n;
            cwv[n][0] = *(const f32x4*)(cw + col); cwv[n][1] = *(const f32x4*)(cw + DFF + col); cwv[n][2] = *(const f32x4*)(cw + 2 * DFF + col); cwv[n][3] = *(const f32x4*)(cb + col); }
        const f32x4 k1 = {-0.1029432392f, -0.1029432392f, -0.1029432392f, -0.1029432392f}, k0 = {-2.3022081985f, -2.3022081985f, -2.3022081985f, -2.3022081985f};
#pragma unroll
        for (int ai = 0; ai < 2; ++ai) {
            const int strip = u.pm * 4 + ai * 2 + wr;
            u32x4 w[4];
#pragma unroll
            for (int n = 0; n < 2; ++n) {
                const int col = colbase + 4 * n;
                f32x4 s2, s3;
#pragma unroll
                for (int j = 0; j < 4; ++j)
                    asm("s_nop 1\n\tv_mov_b32_dpp %0, %2 row_shr:1 row_mask:0xf bank_mask:0xf bound_ctrl:0\n\tv_mov_b32_dpp %1, %3 row_shr:1 row_mask:0xf bank_mask:0xf bound_ctrl:0"
                        : "=&v"(s2[j]), "=&v"(s3[j]) : "v"(acc[ai][0][2][n][j]), "v"(acc[ai][0][3][n][j]));
#pragma unroll
                for (int m = 0; m < 4; ++m) {
                    const f32x4 g = acc[ai][0][m][n], up = acc[ai][1][m][n];
                    const f32x4 p1 = (m == 0) ? s3 : acc[ai][0][m == 0 ? 0 : m - 1][n];
                    const f32x4 p2 = (m == 0) ? s2 : ((m == 1) ? s3 : acc[ai][0][m < 2 ? 0 : m - 2][n]);
                    const f32x4 cv = __builtin_elementwise_fma(cwv[n][2], g, __builtin_elementwise_fma(cwv[n][1], p1, __builtin_elementwise_fma(cwv[n][0], p2, cwv[n][3])));
                    const f32x4 arg = cv * __builtin_elementwise_fma(cv * cv, k1, k0);
                    f32x4 den;
#pragma unroll
                    for (int j = 0; j < 4; ++j) den[j] = __builtin_amdgcn_rcpf(1.0f + __builtin_amdgcn_exp2f(arg[j]));
                    const f32x4 hv = (cv * up) * den;
                    if (n == 0) { w[m].x = pk2(hv[0], hv[1]); w[m].y = pk2(hv[2], hv[3]); } else { w[m].z = pk2(hv[0], hv[1]); w[m].w = pk2(hv[2], hv[3]); }
                    if (m < 2 && fr == 0) { *(f32x4*)(GS + (size_t)(strip * 4 + 2 + m) * DFF + col) = g; *(f32x4*)(US + (size_t)(strip * 2 + m) * DFF + col) = up; }
                    if (m >= 2 && fr == 15) { *(f32x4*)(GS + (size_t)(strip * 4 + (m - 2)) * DFF + col) = g; }
                }
            }
            const int row0 = u.pm * 256 + ai * 128 + wr * 64 + 4 * fr;
#pragma unroll
            for (int m = 0; m < 4; ++m) *(u32x4*)(H + (size_t)(row0 + m) * DFF + colbase) = w[m];
        }
    }
};
struct EpiRope {
    static constexpr bool PERM = true, AFTER_DRAIN = false; static constexpr int REPS = 1;
    static __host__ __device__ __forceinline__ int bmap(int r) { return r; }
    static __host__ __device__ __forceinline__ int amap(int r) { return r; }
    bf16* O; const float* cosT; const float* sinT; float scale;
    __device__ __forceinline__ void operator()(const f32x4 (&acc)[2][2][4][2], const Unit& u, int wr, int wc, int fr, int fq) const {
        const int a4 = 4 * (4 * (wc & 1) + fq);
#pragma unroll
        for (int ai = 0; ai < 2; ++ai)
#pragma unroll
            for (int m = 0; m < 4; ++m) {
                const int tl = u.pm * 256 + ai * 128 + wr * 64 + m * 16 + fr;
                const int b = tl >> 11, t = tl & 2047;
                const f32x4 c4 = *(const f32x4*)(cosT + t * 32 + a4), s4 = *(const f32x4*)(sinT + t * 32 + a4);
#pragma unroll
                for (int bj = 0; bj < 2; ++bj) {
                    const int col = u.pn * 256 + bj * 128 + wc * 32 + fq * 8;
                    const int g = col >> 10, h = (col >> 6) & 15, p0 = col & 63, dsh = 2 * g;
                    const int pos = ((t & ((1 << dsh) - 1)) << (11 - dsh)) + (t >> dsh);
                    const f32x4 x1 = acc[ai][bj][m][0], x2 = acc[ai][bj][m][1];
                    const f32x4 o1 = (x1 * c4 - x2 * s4) * scale, o2 = (x2 * c4 + x1 * s4) * scale;
                    u32x4 w; w.x = pk2(o1[0], o1[1]); w.y = pk2(o1[2], o1[3]); w.z = pk2(o2[0], o2[1]); w.w = pk2(o2[2], o2[3]);
                    *(u32x4*)(O + ((size_t)((g * 16 + b) * 16 + h) * 2048 + pos) * 64 + p0) = w;
                }
            }
    }
};
template <int G> struct EpiVt {
    static constexpr bool PERM = true, AFTER_DRAIN = false; static constexpr int REPS = 1;
    static __host__ __device__ __forceinline__ int bmap(int c) { return G == 0 ? c : (G == 1 ? (4 * (c & 31) + (c >> 5)) : (16 * (c & 7) + (c >> 3))); }
    static __host__ __device__ __forceinline__ int amap(int r) { return r; }
    bf16* V;
    __device__ __forceinline__ void operator()(const f32x4 (&acc)[2][2][4][2], const Unit& u, int wr, int wc, int fr, int fq) const {
        constexpr int L = 2048 >> (2 * G);
        const int b = u.pn >> 3, tis = u.pn & 7;
#pragma unroll
        for (int ai = 0; ai < 2; ++ai)
#pragma unroll
            for (int m = 0; m < 4; ++m) {
                const int vr = u.pm * 256 + ai * 128 + wr * 64 + m * 16 + fr;
                bf16* base = V + (size_t)((G * 16 + b) * 16 + (vr >> 6)) * (2048 * 64) + (size_t)(vr & 63) * L;
#pragma unroll
                for (int bj = 0; bj < 2; ++bj) {
                    int r, mi;
                    if (G == 0) { r = 0; mi = 256 * tis + bj * 128 + wc * 32 + fq * 8; } else if (G == 1) { r = wc; mi = 64 * tis + 32 * bj + fq * 8; } else { r = wc * 4 + fq; mi = 16 * tis + 8 * bj; }
                    const f32x4 v0 = acc[ai][bj][m][0], v1 = acc[ai][bj][m][1];
                    u32x4 w; w.x = pk2(v0[0], v0[1]); w.y = pk2(v0[2], v0[3]); w.z = pk2(v1[0], v1[1]); w.w = pk2(v1[2], v1[3]);
                    *(u32x4*)(base + (size_t)r * 64 * L + mi) = w;
                }
            }
    }
};
struct PoolOrder {
    int G, c, ntiles;
    __device__ bool next(int i, Unit& u) const { const int tile = c + G * (i >> 2); if (tile >= ntiles) return false; u.pm = tile * 4 + (i & 3); u.pn = i & 3; return true; }
    __device__ __forceinline__ void a_ready(const Unit&) const {}
    __device__ __forceinline__ void done(const Unit&) const {}
};

template <class Map>
__device__ __forceinline__ void transpose_w(int K, int N, int ldw, bf16* Wt, const Map& cmap, LAS float* scr, int gw, int ngw, int lane) {
    const int nblk = N / 32, items = (K / 64) * nblk;
    for (int it = gw; it < items; it += ngw) {
        const int kb = it / nblk, nb = it % nblk, k0 = 64 * kb, n0 = 32 * nb;
        const float* src = cmap(n0 + (lane & 31)) + (size_t)(k0 + (lane >> 5)) * ldw;
#pragma unroll 8
        for (int i = 0; i < 32; ++i) scr[(2 * i + (lane >> 5)) * 33 + (lane & 31)] = src[(size_t)(2 * i) * ldw];
        asm volatile("s_waitcnt lgkmcnt(0)" ::: "memory");
        const int c = lane & 7;
#pragma unroll
        for (int j = 0; j < 4; ++j) {
            const int n = (lane >> 3) + 8 * j; const LAS float* s = scr + (8 * c) * 33 + n;
            u32x4 o; o.x = pk2(s[0], s[33]); o.y = pk2(s[2 * 33], s[3 * 33]); o.z = pk2(s[4 * 33], s[5 * 33]); o.w = pk2(s[6 * 33], s[7 * 33]);
            *(u32x4*)(Wt + (size_t)(n0 + n) * K + k0 + 8 * c) = o;
        }
        asm volatile("s_waitcnt lgkmcnt(0)" ::: "memory");
    }
}
struct MapGen { int type; const float* W; const float* W2;
    __device__ __forceinline__ const float* operator()(int n) const {
        if (type == 0) return W + n;
        if (type == 1) { const int p = n & 63; const int dsrc = (p & 4) ? (32 + 4 * (p >> 3) + (p & 3)) : (4 * (p >> 3) + (p & 3)); return W + (n & ~63) + dsrc; }
        const int pn = n >> 8, q = n & 255; return (q < 128) ? (W + pn * 128 + q) : (W2 + pn * 128 + q - 128);
    } };
template <class PT> __device__ __forceinline__ void prep_phase(const PT& p, LAS unsigned char* lds, int gw, int ngw, int lane, int wave) {
    LAS float* scr = (LAS float*)(lds + wave * 16384);
    unsigned char* ws = p.ws;
    for (int mi = 0; mi < 22; ++mi) {
        int K, N, ldw; bf16* Wt; MapGen mp; mp.W2 = nullptr;
        if (mi < 8) { K = 256; N = 256; ldw = 256; Wt = (bf16*)(ws + WS_WPOOL) + (size_t)mi * 65536; mp.type = 0; mp.W = p.pool_w + (size_t)mi * 65536; }
        else if (mi < 12) { const int l = mi - 8; K = DM; N = 2 * DFF; ldw = DFF; Wt = (bf16*)(ws + WS_WGU) + (size_t)l * 2 * DFF * DM; mp.type = 2; mp.W = p.w_gate + (size_t)l * DM * DFF; mp.W2 = p.w_up + (size_t)l * DM * DFF; }
        else if (mi < 16) { const int l = mi - 12; K = DFF; N = DM; ldw = DM; Wt = (bf16*)(ws + WS_WDOWN) + (size_t)l * DM * DFF; mp.type = 0; mp.W = p.w_down + (size_t)l * DFF * DM; }
        else if (mi < 18) { const int j = mi - 16; K = DM; N = QD; ldw = QD; Wt = (bf16*)(ws + WS_WQ) + (size_t)j * QD * DM; mp.type = 1; mp.W = p.w_q + (size_t)j * DM * QD; }
        else if (mi < 20) { const int j = mi - 18; K = DM; N = DM; ldw = DM; Wt = (bf16*)(ws + WS_WO) + (size_t)j * DM * DM; mp.type = 0; mp.W = p.w_o + (size_t)j * DM * DM; }
        else if (mi == 20) { K = DM; N = QD; ldw = 2 * QD; Wt = (bf16*)(ws + WS_WK); mp.type = 1; mp.W = p.w_kv; }
        else { K = DM; N = QD; ldw = 2 * QD; Wt = (bf16*)(ws + WS_WV); mp.type = 0; mp.W = p.w_kv + QD; }
        transpose_w(K, N, ldw, Wt, mp, scr, gw, ngw, lane);
    }
    float* cosT = (float*)(ws + WS_ROPE); float* sinT = cosT + SEQ * 32;
    for (int i = gw * 64 + lane; i < SEQ * 32; i += ngw * 64) {
        const int t = i >> 5, f = i & 31;
        const double rev = (double)t * p.inv_freq[f] * 0.15915494309189535;
        const float fr = (float)(rev - rint(rev));
        cosT[i] = __builtin_amdgcn_cosf(fr); sinT[i] = __builtin_amdgcn_sinf(fr);
    }
}

__device__ __forceinline__ void pool_phase(const float* xin, bf16* PA, int gtid, int nthr) {
    for (int idx = gtid; idx < (MTOK / 32) * 128; idx += nthr) {
        const int run = idx >> 7, rem = idx & 127, g = rem >> 5, ch = rem & 31;
        const int w = 2 << g, ts = run * 32, pos0 = ts & 2047;
        const float* px = xin + (size_t)ts * DM + g * 256 + ch * 8;
        f32x4 s0 = {0.f, 0.f, 0.f, 0.f}, s1 = {0.f, 0.f, 0.f, 0.f};
        const int nb = (pos0 < w) ? pos0 : w;
        for (int j = 1; j <= nb; ++j) { s0 += *(const f32x4*)(px - (size_t)j * DM); s1 += *(const f32x4*)(px - (size_t)j * DM + 4); }
        bf16* po = PA + ((size_t)((ts >> 8) * 4 + g) * 256 + (ts & 255)) * 256 + ch * 8;
#pragma unroll 4
        for (int i = 0; i < 32; ++i) {
            const int pos = pos0 + i;
            const f32x4 x0 = *(const f32x4*)(px + (size_t)i * DM), x1 = *(const f32x4*)(px + (size_t)i * DM + 4);
            s0 += x0; s1 += x1;
            if (pos >= w) { s0 -= *(const f32x4*)(px + (size_t)(i - w) * DM); s1 -= *(const f32x4*)(px + (size_t)(i - w) * DM + 4); }
            const float ic = 1.0f / (float)((pos + 1 < w) ? (pos + 1) : w);
            const f32x4 a0 = s0 * ic - x0, a1 = s1 * ic - x1;
            u32x4 o; o.x = pk2(a0[0], a0[1]); o.y = pk2(a0[2], a0[3]); o.z = pk2(a1[0], a1[1]); o.w = pk2(a1[2], a1[3]);
            *(u32x4*)(po + (size_t)i * 256) = o;
        }
    }
}
__device__ __forceinline__ void wave_sum2(float& a, float& b, int lane) {
    float t, u;
    asm("s_nop 1\n\tv_add_f32_dpp %0, %2, %2 quad_perm:[1,0,3,2] row_mask:0xf bank_mask:0xf\n\tv_add_f32_dpp %1, %3, %3 quad_perm:[1,0,3,2] row_mask:0xf bank_mask:0xf" : "=&v"(t), "=&v"(u) : "v"(a), "v"(b));
    asm("s_nop 1\n\tv_add_f32_dpp %0, %2, %2 quad_perm:[2,3,0,1] row_mask:0xf bank_mask:0xf\n\tv_add_f32_dpp %1, %3, %3 quad_perm:[2,3,0,1] row_mask:0xf bank_mask:0xf" : "=&v"(a), "=&v"(b) : "v"(t), "v"(u));
    asm("s_nop 1\n\tv_add_f32_dpp %0, %2, %2 row_half_mirror row_mask:0xf bank_mask:0xf\n\tv_add_f32_dpp %1, %3, %3 row_half_mirror row_mask:0xf bank_mask:0xf" : "=&v"(t), "=&v"(u) : "v"(a), "v"(b));
    asm("s_nop 1\n\tv_add_f32_dpp %0, %2, %2 row_mirror row_mask:0xf bank_mask:0xf\n\tv_add_f32_dpp %1, %3, %3 row_mirror row_mask:0xf bank_mask:0xf" : "=&v"(a), "=&v"(b) : "v"(t), "v"(u));
    a += shfl_xor_l(a, 16, lane); b += shfl_xor_l(b, 16, lane);
    a += shfl_xor_l(a, 32, lane); b += shfl_xor_l(b, 32, lane);
}
__device__ __forceinline__ float fp8lo(unsigned w, int k) { return k == 0 ? __builtin_amdgcn_cvt_f32_fp8((int)w, 0) : k == 1 ? __builtin_amdgcn_cvt_f32_fp8((int)w, 1) : k == 2 ? __builtin_amdgcn_cvt_f32_fp8((int)w, 2) : __builtin_amdgcn_cvt_f32_fp8((int)w, 3); }
template <bool IN_SPLIT, bool OUT_SPLIT>
__device__ __forceinline__ void addln_phase(const float* base, float* S, const bf16* F, bf16* XB, const float* gB, const float* bB, int nrows, int gw, int ngw, int lane) {
    f32x4 gb[4], bb[4];
#pragma unroll
    for (int j = 0; j < 2; ++j)
#pragma unroll
        for (int h = 0; h < 2; ++h) { gb[2 * j + h] = *(const f32x4*)(gB + 8 * lane + 512 * j + 4 * h); bb[2 * j + h] = *(const f32x4*)(bB + 8 * lane + 512 * j + 4 * h); }
    u32x4 fw[2], hw[2]; u32x2 lw[2]; f32x4 xv[4];
#define ADDLN_LOAD(ROW) do { const size_t ro_ = (size_t)(ROW) * DM + 8 * lane; \
        _Pragma("unroll") for (int j = 0; j < 2; ++j) fw[j] = *(const u32x4*)(F + ro_ + 512 * j); \
        if (IN_SPLIT) { const unsigned char* lo_ = (const unsigned char*)(S + (size_t)(ROW) * DM) + 8 * lane; \
            _Pragma("unroll") for (int j = 0; j < 2; ++j) { hw[j] = *(const u32x4*)(XB + ro_ + 512 * j); lw[j] = *(const u32x2*)(lo_ + 512 * j); } } \
        else { _Pragma("unroll") for (int j = 0; j < 2; ++j) { xv[2 * j] = *(const f32x4*)(base + ro_ + 512 * j); xv[2 * j + 1] = *(const f32x4*)(base + ro_ + 512 * j + 4); } } } while (0)
    if (gw < nrows) ADDLN_LOAD(gw);
    for (int row = gw; row < nrows; row += ngw) {
        const size_t ro = (size_t)row * DM + 8 * lane;
        unsigned char* lo = (unsigned char*)(S + (size_t)row * DM) + 8 * lane;
        f32x4 v[4]; float s = 0.f, q = 0.f;
#pragma unroll
        for (int j = 0; j < 2; ++j)
#pragma unroll
            for (int h = 0; h < 2; ++h) {
                const int c = 2 * j + h;
                if (IN_SPLIT) { const unsigned h0 = hw[j][2 * h], h1 = hw[j][2 * h + 1], l4 = lw[j][h];
                    v[c][0] = bflo(h0) + fp8lo(l4, 0) * (1.0f / 512.0f); v[c][1] = bfhi(h0) + fp8lo(l4, 1) * (1.0f / 512.0f);
                    v[c][2] = bflo(h1) + fp8lo(l4, 2) * (1.0f / 512.0f); v[c][3] = bfhi(h1) + fp8lo(l4, 3) * (1.0f / 512.0f); }
                else v[c] = xv[c];
                const unsigned f0 = fw[j][2 * h], f1 = fw[j][2 * h + 1];
                const f32x4 f = {bflo(f0), bfhi(f0), bflo(f1), bfhi(f1)};
                v[c] = v[c] * ALPHA + f;
                s += (v[c][0] + v[c][1]) + (v[c][2] + v[c][3]);
                q += (v[c][0] * v[c][0] + v[c][1] * v[c][1]) + (v[c][2] * v[c][2] + v[c][3] * v[c][3]);
            }
        const int nrow = row + ngw;
        if (nrow < nrows) ADDLN_LOAD(nrow);
        wave_sum2(s, q, lane);
        const float mean = s * (1.0f / DM);
        const float rstd = 1.0f / sqrtf(fmaxf(q * (1.0f / DM) - mean * mean, 0.f) + LN_EPS);
#pragma unroll
        for (int j = 0; j < 2; ++j) {
            const f32x4 y0 = (v[2 * j] - mean) * rstd * gb[2 * j] + bb[2 * j], y1 = (v[2 * j + 1] - mean) * rstd * gb[2 * j + 1] + bb[2 * j + 1];
            if (OUT_SPLIT) {
                u32x4 w; w.x = pk2(y0[0], y0[1]); w.y = pk2(y0[2], y0[3]); w.z = pk2(y1[0], y1[1]); w.w = pk2(y1[2], y1[3]);
                int l0 = 0, l1 = 0;
                l0 = __builtin_amdgcn_cvt_pk_fp8_f32((y0[0] - bflo(w.x)) * 512.0f, (y0[1] - bfhi(w.x)) * 512.0f, l0, false);
                l0 = __builtin_amdgcn_cvt_pk_fp8_f32((y0[2] - bflo(w.y)) * 512.0f, (y0[3] - bfhi(w.y)) * 512.0f, l0, true);
                l1 = __builtin_amdgcn_cvt_pk_fp8_f32((y1[0] - bflo(w.z)) * 512.0f, (y1[1] - bfhi(w.z)) * 512.0f, l1, false);
                l1 = __builtin_amdgcn_cvt_pk_fp8_f32((y1[2] - bflo(w.w)) * 512.0f, (y1[3] - bfhi(w.w)) * 512.0f, l1, true);
                u32x2 l; l.x = (unsigned)l0; l.y = (unsigned)l1;
                *(u32x4*)(XB + ro + 512 * j) = w; *(u32x2*)(lo + 512 * j) = l;
            } else { *(f32x4*)(S + ro + 512 * j) = y0; *(f32x4*)(S + ro + 512 * j + 4) = y1; }
        }
    }
#undef ADDLN_LOAD
}
__device__ __forceinline__ void fixup_phase(bf16* H, const float* GS, const float* US, const float* cw, const float* cb, int nstrips, int gtid, int nthr) {
    const int total = nstrips * 2 * (DFF / 4);
    for (int idx = gtid; idx < total; idx += nthr) {
        const int cq = idx % (DFF / 4), rest = idx / (DFF / 4), lr = rest & 1, strip = rest >> 1, col = 4 * cq;
        const bool first = ((strip & 31) == 0);
        const f32x4 z = {0.f, 0.f, 0.f, 0.f};
        const f32x4 pm2 = first ? z : *(const f32x4*)(GS + (size_t)((strip - 1) * 4 + 0) * DFF + col);
        const f32x4 pm1 = first ? z : *(const f32x4*)(GS + (size_t)((strip - 1) * 4 + 1) * DFF + col);
        const f32x4 c0 = *(const f32x4*)(GS + (size_t)(strip * 4 + 2) * DFF + col), c1 = *(const f32x4*)(GS + (size_t)(strip * 4 + 3) * DFF + col);
        const f32x4 up = *(const f32x4*)(US + (size_t)(strip * 2 + lr) * DFF + col);
        const f32x4 w0 = *(const f32x4*)(cw + col), w1 = *(const f32x4*)(cw + DFF + col), w2 = *(const f32x4*)(cw + 2 * DFF + col), b4 = *(const f32x4*)(cb + col);
        const f32x4 ga = lr ? pm1 : pm2, gb = lr ? c0 : pm1, gc = lr ? c1 : c0;
        const f32x4 cv = b4 + w0 * ga + w1 * gb + w2 * gc;
        f32x4 hv;
#pragma unroll
        for (int j = 0; j < 4; ++j) hv[j] = gelu_tanh(cv[j]) * up[j];
        u32x2 w; w.x = pk2(hv[0], hv[1]); w.y = pk2(hv[2], hv[3]);
        *(u32x2*)(H + (size_t)(strip * 64 + lr) * DFF + col) = w;
    }
}
__device__ __forceinline__ void attn_block(f32x16& o0, f32x16& o1, float& mrun, float& lrun, const bf16x8 (&bq)[4], const bf16x8 (&kf)[4], const bf16x8 (&vf)[2][2], int kb, int qpos, int hl, int lane) {
    f32x16 s;
#pragma unroll
    for (int i = 0; i < 16; ++i) s[i] = 0.f;
#pragma unroll
    for (int k = 0; k < 4; ++k) s = __builtin_amdgcn_mfma_f32_32x32x16_bf16(kf[k], bq[k], s, 0, 0, 0);
    float mloc = -1e30f;
#pragma unroll
    for (int i = 0; i < 16; ++i) {
        const int kpos = kb + 16 * (i >> 3) + 8 * hl + (i & 7);
        const bool ok = (kpos <= qpos) && (kpos + 128 >= qpos);
        s[i] = ok ? s[i] : -1e30f; mloc = fmaxf(mloc, s[i]);
    }
    mloc = fmaxf(mloc, shfl_xor_l(mloc, 32, lane));
    const float mnew = fmaxf(mrun, mloc), al = __builtin_amdgcn_exp2f(mrun - mnew);
    float ps = 0.f;
#pragma unroll
    for (int i = 0; i < 16; ++i) { s[i] = __builtin_amdgcn_exp2f(s[i] - mnew); ps += s[i]; }
    lrun = lrun * al + ps; mrun = mnew;
#pragma unroll
    for (int i = 0; i < 16; ++i) { o0[i] *= al; o1[i] *= al; }
    u32x4 p0, p1;
    p0.x = pk2(s[0], s[1]); p0.y = pk2(s[2], s[3]); p0.z = pk2(s[4], s[5]); p0.w = pk2(s[6], s[7]);
    p1.x = pk2(s[8], s[9]); p1.y = pk2(s[10], s[11]); p1.z = pk2(s[12], s[13]); p1.w = pk2(s[14], s[15]);
    const bf16x8 pb0 = __builtin_bit_cast(bf16x8, p0), pb1 = __builtin_bit_cast(bf16x8, p1);
    o0 = __builtin_amdgcn_mfma_f32_32x32x16_bf16(vf[0][0], pb0, o0, 0, 0, 0);
    o0 = __builtin_amdgcn_mfma_f32_32x32x16_bf16(vf[0][1], pb1, o0, 0, 0, 0);
    o1 = __builtin_amdgcn_mfma_f32_32x32x16_bf16(vf[1][0], pb0, o1, 0, 0, 0);
    o1 = __builtin_amdgcn_mfma_f32_32x32x16_bf16(vf[1][1], pb1, o1, 0, 0, 0);
}
__device__ __forceinline__ void attn_store(bf16* orow, float* lsep, f32x16& o0, f32x16& o1, float mrun, float lrun, int hl, int lane, bool dry) {
    lrun += shfl_xor_l(lrun, 32, lane);
    const float inv = 1.0f / lrun;
#pragma unroll
    for (int dt = 0; dt < 2; ++dt) {
        const f32x16& o = dt ? o1 : o0;
        u32x2 w[4];
#pragma unroll
        for (int a = 0; a < 4; ++a) { w[a].x = pk2(o[4 * a] * inv, o[4 * a + 1] * inv); w[a].y = pk2(o[4 * a + 2] * inv, o[4 * a + 3] * inv); }
#pragma unroll
        for (int pr = 0; pr < 2; ++pr) {
            const u32x2 snd = hl ? w[2 * pr] : w[2 * pr + 1], own = hl ? w[2 * pr + 1] : w[2 * pr];
            u32x2 rcv;
            rcv.x = (unsigned)__builtin_amdgcn_ds_bpermute((lane ^ 32) << 2, (int)snd.x); rcv.y = (unsigned)__builtin_amdgcn_ds_bpermute((lane ^ 32) << 2, (int)snd.y);
            u32x4 c; if (hl) { c.x = rcv.x; c.y = rcv.y; c.z = own.x; c.w = own.y; } else { c.x = own.x; c.y = own.y; c.z = rcv.x; c.w = rcv.y; }
            if (!dry) *(u32x4*)(orow + 32 * dt + 8 * (2 * pr + hl)) = c;
        }
    }
    if (hl == 0 && !dry) *lsep = mrun + __builtin_amdgcn_logf(lrun);
}
__device__ __forceinline__ void attn_phase(bf16* Qb, const bf16* Kb, const bf16* Vt, float* LSE, int gw, int ngw, int lane, bool dry) {
    const int n = lane & 31, hl = lane >> 5;
    const int kperm = (n & ~12) | ((n & 4) << 1) | ((n & 8) >> 1);
    for (int u = gw; u < 3 * 8192; u += ngw) {
        const int g = u >> 13, v = u & 8191, dsh = 2 * g, L = 2048 >> dsh, ncl = 5 - dsh;
        const int rest = v >> ncl, r = rest & ((1 << dsh) - 1), bh = rest >> dsh;
        const int qc = ((v & ((1 << ncl) - 1)) + (rest >> (11 - ncl))) & ((1 << ncl) - 1);
        const size_t hb = (size_t)(g * 256 + bh) * (2048 * 64);
        bf16* qs = Qb + hb + (size_t)(r * L) * 64;
        const bf16* ks = Kb + hb + (size_t)(r * L) * 64;
        const bf16* vs = Vt + hb + (size_t)r * 64 * L;
        const int q0 = qc * 64, qposA = q0 + n, qposB = q0 + 32 + n;
        bf16x8 bqA[4], bqB[4];
#pragma unroll
        for (int k = 0; k < 4; ++k) { bqA[k] = *(const bf16x8*)(qs + (size_t)qposA * 64 + k * 16 + hl * 8); bqB[k] = *(const bf16x8*)(qs + (size_t)qposB * 64 + k * 16 + hl * 8); }
        f32x16 oA0, oA1, oB0, oB1;
#pragma unroll
        for (int i = 0; i < 16; ++i) { oA0[i] = 0.f; oA1[i] = 0.f; oB0[i] = 0.f; oB1[i] = 0.f; }
        float mA = -1e30f, lA = 0.f, mB = -1e30f, lB = 0.f;
        int kb0 = q0 - 128; if (kb0 < 0) kb0 = 0;
        const int kbl = q0 + 32;
        bf16x8 kf[4], vf[2][2], kfn[4], vfn[2][2];
#pragma unroll
        for (int k = 0; k < 4; ++k) kf[k] = *(const bf16x8*)(ks + (size_t)(kb0 + kperm) * 64 + k * 16 + hl * 8);
#pragma unroll
        for (int dt = 0; dt < 2; ++dt)
#pragma unroll
            for (int c = 0; c < 2; ++c) vf[dt][c] = *(const bf16x8*)(vs + (size_t)(32 * dt + n) * L + kb0 + 16 * c + 8 * hl);
        for (int kb = kb0; kb <= kbl; kb += 32) {
            asm volatile("" :: "v"(kf[0]), "v"(kf[1]), "v"(kf[2]), "v"(kf[3]), "v"(vf[0][0]), "v"(vf[0][1]), "v"(vf[1][0]), "v"(vf[1][1]));
            const int kn = (kb + 32 <= kbl) ? kb + 32 : kb;
#pragma unroll
            for (int k = 0; k < 4; ++k) kfn[k] = *(const bf16x8*)(ks + (size_t)(kn + kperm) * 64 + k * 16 + hl * 8);
#pragma unroll
            for (int dt = 0; dt < 2; ++dt)
#pragma unroll
                for (int c = 0; c < 2; ++c) vfn[dt][c] = *(const bf16x8*)(vs + (size_t)(32 * dt + n) * L + kn + 16 * c + 8 * hl);
            if (kb <= q0) attn_block(oA0, oA1, mA, lA, bqA, kf, vf, kb, qposA, hl, lane);
            if (kb >= q0 - 96) attn_block(oB0, oB1, mB, lB, bqB, kf, vf, kb, qposB, hl, lane);
#pragma unroll
            for (int k = 0; k < 4; ++k) kf[k] = kfn[k];
#pragma unroll
            for (int dt = 0; dt < 2; ++dt)
#pragma unroll
                for (int c = 0; c < 2; ++c) vf[dt][c] = vfn[dt][c];
        }
        float* lp = LSE + (size_t)(g * 256 + bh) * 2048 + r * L;
        attn_store(qs + (size_t)qposA * 64, lp + qposA, oA0, oA1, mA, lA, hl, lane, dry);
        attn_store(qs + (size_t)qposB * 64, lp + qposB, oB0, oB1, mB, lB, hl, lane, dry);
    }
}
__device__ __forceinline__ void combine_phase(const bf16* Ob, const float* LSE, bf16* ATT, int gtid, int nthr) {
    for (int idx = gtid; idx < MH * 128; idx += nthr) {
        const int oct = idx & 7, h = (idx >> 3) & 15, tl = idx >> 7, b = tl >> 11, t = tl & 2047;
        float l[3]; u32x4 ov[3];
#pragma unroll
        for (int g = 0; g < 3; ++g) {
            const int dsh = 2 * g, pos = ((t & ((1 << dsh) - 1)) << (11 - dsh)) + (t >> dsh);
            const size_t ro = (size_t)((g * 16 + b) * 16 + h) * 2048 + pos;
            l[g] = LSE[ro]; ov[g] = *(const u32x4*)(Ob + ro * 64 + oct * 8);
        }
        const float mx = fmaxf(l[0], fmaxf(l[1], l[2]));
        float w[3];
#pragma unroll
        for (int g = 0; g < 3; ++g) w[g] = __builtin_amdgcn_exp2f(l[g] - mx);
        const float inv = 1.0f / (w[0] + w[1] + w[2]);
        u32x4 o;
#pragma unroll
        for (int e = 0; e < 4; ++e) {
            float lo = 0.f, hi = 0.f;
#pragma unroll
            for (int g = 0; g < 3; ++g) { lo += w[g] * bflo(ov[g][e]); hi += w[g] * bfhi(ov[g][e]); }
            o[e] = pk2(lo * inv, hi * inv);
        }
        *(u32x4*)(ATT + (size_t)tl * DM + h * 64 + oct * 8) = o;
    }
}

#define XB_TMO      128
#define XB_XCNT(j)  (256  + 64 * (j))
#define XB_XSUB(j)  (1280 + 64 * (j))
#define XB_XGEN(j)  (2304 + 64 * (j))
#define XB_TOP      3328
#define XB_TOPGEN   3392
#define XCD_BAR_WORDS 3456
#define XB_SPIN_CAP (1u << 22)
__device__ __forceinline__ unsigned xb_ld(unsigned* p)              { return __hip_atomic_load(p, __ATOMIC_RELAXED, __HIP_MEMORY_SCOPE_AGENT); }
__device__ __forceinline__ unsigned xb_add(unsigned* p, unsigned v) { return __hip_atomic_fetch_add(p, v, __ATOMIC_RELAXED, __HIP_MEMORY_SCOPE_AGENT); }
__device__ __forceinline__ unsigned xb_xcc_id() { return (unsigned)__builtin_amdgcn_s_getreg((3 << 11) | 20) & 0xFu; }
#define XB_SPIN(cond, bar) do { unsigned _sp = 0; while (cond) { __builtin_amdgcn_s_sleep(1); \
    if ((++_sp & 255u) == 0u) { if (xb_ld(&(bar)[XB_TMO])) break; if (_sp > XB_SPIN_CAP) { atomicAdd(&(bar)[XB_TMO], 1u); break; } } } } while (0)
__device__ __forceinline__ void xcd_barrier_complete(unsigned* bar, unsigned x, unsigned& nloc, unsigned& nx) {
    const unsigned G = gridDim.x * gridDim.y * gridDim.z;
    unsigned sum, cnt, mine, sp = 0u;
    for (;;) {
        sum = 0u; cnt = 0u; mine = 0u;
#pragma unroll
        for (unsigned j = 0; j < 16; ++j) { const unsigned c = xb_ld(&bar[XB_XCNT(j)]); sum += c; cnt += (c > 0u) ? 1u : 0u; mine = (j == x) ? c : mine; }
        if (sum == G) break;
        __builtin_amdgcn_s_sleep(1);
        if ((++sp & 255u) == 0u) { if (xb_ld(&bar[XB_TMO])) break; if (sp > XB_SPIN_CAP) { atomicAdd(&bar[XB_TMO], 1u); break; } }
    }
    nloc = mine > 0u ? mine : 1u; nx = cnt > 0u ? cnt : 1u;
}
__device__ __forceinline__ void xcd_barrier(unsigned* bar, unsigned x, volatile LAS unsigned* st, int tid) {
    asm volatile("s_waitcnt vmcnt(0)" ::: "memory");
    __syncthreads();
    if (tid == 0) {
        __builtin_amdgcn_s_waitcnt(0);
        unsigned nloc = st[0], nx = st[1];
        if (nloc == 0u) { xcd_barrier_complete(bar, x, nloc, nx); st[0] = nloc; st[1] = nx; }
        const unsigned old = xb_add(&bar[XB_XSUB(x)], 1u);
        const unsigned gen = old / nloc;
        if (old + 1u == (gen + 1u) * nloc) {
            __builtin_amdgcn_fence(__ATOMIC_RELEASE, "agent");
            asm volatile("s_waitcnt vmcnt(0)" ::: "memory");
            const unsigned og = xb_add(&bar[XB_TOP], 1u);
            const unsigned tg = og / nx;
            if (og + 1u == (tg + 1u) * nx) xb_add(&bar[XB_TOPGEN], 1u);
            else XB_SPIN(xb_ld(&bar[XB_TOPGEN]) == tg, bar);
            __builtin_amdgcn_fence(__ATOMIC_ACQUIRE, "agent");
            xb_add(&bar[XB_XGEN(x)], 1u);
            asm volatile("s_waitcnt vmcnt(0)" ::: "memory");
        } else {
            XB_SPIN(xb_ld(&bar[XB_XGEN(x)]) == gen, bar);
            __builtin_amdgcn_fence(__ATOMIC_ACQUIRE, "agent");
            asm volatile("s_waitcnt vmcnt(0)" ::: "memory");
        }
    }
    __syncthreads();
}

__device__ __forceinline__ int get_lane() { int l; asm volatile("v_mbcnt_lo_u32_b32 %0, -1, 0\n\tv_mbcnt_hi_u32_b32 %0, -1, %0" : "=&v"(l)); return l; }
enum Kind { K_PREP = 0, K_POOL, K_POOLGEMM, K_LN1, K_GU, K_FIXUP, K_DOWN, K_LN2, K_KV, K_QPROJ, K_ATTN, K_COMBINE, K_OPROJ };
constexpr int NPH = 1 + 14 + 2 * 19;
__global__ void __launch_bounds__(NTHREADS, 2) yoco_fwd(Params p_unused) {
    extern __shared__ __attribute__((aligned(16))) unsigned char lds_raw[];
    LAS unsigned char* lds = (LAS unsigned char*)lds_raw;
    cg::grid_group grid = cg::this_grid();
    typedef const Params __attribute__((address_space(4))) CParams;
    CParams* pp0 = (CParams*)__builtin_amdgcn_kernarg_segment_ptr();
    const int wave0 = __builtin_amdgcn_readfirstlane((int)threadIdx.x >> 6);
    volatile LAS unsigned* bst = (volatile LAS unsigned*)(lds + 131072);
    if (threadIdx.x < 4) bst[threadIdx.x] = 0u;
    __syncthreads();
    unsigned* bar = (unsigned*)(pp0->ws + WS_BAR);
    const unsigned xcc = xb_xcc_id();
    if (threadIdx.x == 0) (void)xb_add(&bar[XB_XCNT(xcc)], 1u);
    grid.sync();
    const int hi = pp0->ph_hi < NPH ? pp0->ph_hi : NPH;
    for (int ph = pp0->ph_lo; ph < hi; ++ph) {
        CParams* pq = pp0; asm volatile("" : "+s"(pq));
        CParams& p = *pq;
        int wave = wave0, bx = blockIdx.x, G = gridDim.x;
        asm volatile("" : "+s"(wave)); asm volatile("" : "+s"(bx)); asm volatile("" : "+s"(G));
        const int gw = bx * NWAVES + wave, ngw = G * NWAVES, nthr = G * NTHREADS;
#define LT const int lane = get_lane(), tid = wave * 64 + lane, gtid = bx * NTHREADS + tid; (void)lane; (void)tid; (void)gtid;
        int kind, layer = 0, half = 0; bool full = true;
        if (ph == 0) kind = K_PREP;
        else if (ph < 15) { layer = (ph - 1) / 7; kind = K_POOL + (ph - 1) % 7; }
        else {
            const int q = ph - 15, r = q % 19; half = q / 19; full = false;
            if (r == 0) kind = K_KV;
            else { const int k = (r - 1) % 9; layer = 2 + (r - 1) / 9; kind = k == 0 ? K_QPROJ : k == 1 ? K_ATTN : k == 2 ? K_COMBINE : k == 3 ? K_OPROJ : k == 4 ? K_LN1 : k == 5 ? K_GU : k == 6 ? K_FIXUP : k == 7 ? K_DOWN : K_LN2; }
        }
        unsigned char* ws = p.ws;
        const int nrows = full ? MTOK : MH; const size_t roff = full ? 0 : (size_t)half * MH;
        float* Sh = p.out + roff * DM; bf16* XBh = (bf16*)(ws + WS_XB) + roff * DM;
        bf16* HB = (bf16*)(ws + WS_H);
        switch (kind) {
        case K_PREP: { LT prep_phase(p, lds, gw, ngw, lane, wave); } break;
        case K_POOL: { LT pool_phase(layer == 0 ? p.x : p.out, HB, gtid, nthr); } break;
        case K_POOLGEMM: { LT
            pg8::Gemm g{HB, (const bf16*)(ws + WS_WPOOL) + (size_t)layer * 4 * 65536, MTOK * 4, 1024, 256};
            PoolOrder O{G, bx, MTOK / 256}; EpiF E{(bf16*)(ws + WS_FA), p.pool_scale + layer * DM, true};
            pg8::gemm_phase<EpiF, PoolOrder, true, true>(lds, g, O, E, tid);
        } break;
        case K_LN1: { LT
            if (full) addln_phase<false, true>(layer == 0 ? p.x : p.out, Sh, (const bf16*)(ws + WS_FA), XBh, p.ln1_g + layer * DM, p.ln1_b + layer * DM, nrows, gw, ngw, lane);
            else addln_phase<true, true>(Sh, Sh, (const bf16*)(ws + WS_H), XBh, p.ln1_g + layer * DM, p.ln1_b + layer * DM, nrows, gw, ngw, lane);
        } break;
        case K_LN2: { LT
            const bf16* Fp = full ? (const bf16*)(ws + WS_FA) : (const bf16*)(ws + WS_ATT);
            if (layer == 0 || layer == 3) addln_phase<true, false>(Sh, Sh, Fp, XBh, p.ln2_g + layer * DM, p.ln2_b + layer * DM, nrows, gw, ngw, lane);
            else addln_phase<true, true>(Sh, Sh, Fp, XBh, p.ln2_g + layer * DM, p.ln2_b + layer * DM, nrows, gw, ngw, lane);
        } break;
        case K_GU: { LT
            pg8::Gemm g{XBh, (const bf16*)(ws + WS_WGU) + (size_t)layer * 2 * DFF * DM, nrows, 2 * DFF, DM};
            pg8::StaticOrder O; O.init(nrows, 2 * DFF, G, bx);
            EpiGU E{HB, (float*)(ws + WS_GS), (float*)(ws + WS_US), p.conv_w + (size_t)layer * 3 * DFF, p.conv_b + (size_t)layer * DFF};
            pg8::gemm_phase<EpiGU, pg8::StaticOrder, true, true>(lds, g, O, E, tid);
        } break;
        case K_FIXUP: { LT fixup_phase(HB, (const float*)(ws + WS_GS), (const float*)(ws + WS_US), p.conv_w + (size_t)layer * 3 * DFF, p.conv_b + (size_t)layer * DFF, nrows / 64, gtid, nthr); } break;
        case K_DOWN: case K_OPROJ: { LT
            const bool dn = (kind == K_DOWN);
            pg8::Gemm g{dn ? (const bf16*)HB : (const bf16*)(ws + WS_ATT), dn ? (const bf16*)(ws + WS_WDOWN) + (size_t)layer * DM * DFF : (const bf16*)(ws + WS_WO) + (size_t)(layer - 2) * DM * DM, nrows, DM, dn ? DFF : DM};
            pg8::StaticOrder O; O.init(nrows, DM, G, bx);
            EpiF E{dn ? (full ? (bf16*)(ws + WS_FA) : (bf16*)(ws + WS_ATT)) : HB, nullptr, false};
            pg8::gemm_phase<EpiF, pg8::StaticOrder, true, true>(lds, g, O, E, tid);
        } break;
        case K_KV: case K_QPROJ: { LT
            const bool isq = (kind == K_QPROJ);
            const float* cosT = (const float*)(ws + WS_ROPE);
            pg8::Gemm g{XBh, isq ? (const bf16*)(ws + WS_WQ) + (size_t)(layer - 2) * QD * DM : (const bf16*)(ws + WS_WK), MH, QD, DM};
            pg8::StaticOrder O; O.init(MH, QD, G, bx); EpiRope E{isq ? HB : (bf16*)(ws + WS_K), cosT, cosT + SEQ * 32, isq ? QSCALE : 1.0f};
            pg8::gemm_phase<EpiRope, pg8::StaticOrder, true, true>(lds, g, O, E, tid);
            if (!isq) {
                bf16* VB = (bf16*)(ws + WS_V);
                pg8::StaticOrder OV; OV.init(DM, MH, G, bx);
                { pg8::Gemm gv{(const bf16*)(ws + WS_WV), XBh, DM, MH, DM}; EpiVt<0> EV{VB}; pg8::gemm_phase<EpiVt<0>, pg8::StaticOrder, true, true>(lds, gv, OV, EV, tid); }
                { pg8::Gemm gv{(const bf16*)(ws + WS_WV) + (size_t)DM * DM, XBh, DM, MH, DM}; EpiVt<1> EV{VB}; pg8::gemm_phase<EpiVt<1>, pg8::StaticOrder, true, true>(lds, gv, OV, EV, tid); }
                { pg8::Gemm gv{(const bf16*)(ws + WS_WV) + (size_t)2 * DM * DM, XBh, DM, MH, DM}; EpiVt<2> EV{VB}; pg8::gemm_phase<EpiVt<2>, pg8::StaticOrder, true, true>(lds, gv, OV, EV, tid); }
            }
        } break;
        case K_ATTN: { LT
            const int vb = ((G & 7) == 0) ? (bx & 7) * (G >> 3) + (bx >> 3) : bx;
            attn_phase(HB, (const bf16*)(ws + WS_K), (const bf16*)(ws + WS_V), (float*)(ws + WS_LSE), vb * NWAVES + wave, ngw, lane, false); } break;
        case K_COMBINE: { LT combine_phase(HB, (const float*)(ws + WS_LSE), (bf16*)(ws + WS_ATT), gtid, nthr); } break;
        default: break;
        }
        const bool nosync = (kind == K_PREP || kind == K_KV);
        if (ph + 1 < hi && !nosync) xcd_barrier(bar, xcc, bst, wave * 64 + get_lane());
#undef LT
    }
}

extern "C" void kernel_launch(void* const* d_in, const int* in_sizes, int n_in, void* d_out, int out_size, void* d_ws, size_t ws_size, hipStream_t stream) {
    static int grid = 0;
    if (grid == 0) {
        if (n_in != 15 || out_size != MTOK * DM || ws_size < WS_END) { fprintf(stderr, "kernel_launch: unexpected shapes (n_in %d, out %d, ws %zu)\n", n_in, out_size, ws_size); grid = -1; return; }
        int dev = 0, cus = 0, per_cu = 0;
        hipGetDevice(&dev);
        hipDeviceGetAttribute(&cus, hipDeviceAttributeMultiprocessorCount, dev);
        if (hipFuncSetAttribute((const void*)yoco_fwd, hipFuncAttributeMaxDynamicSharedMemorySize, LDS_BYTES) != hipSuccess) { fprintf(stderr, "kernel_launch: hipFuncSetAttribute failed\n"); grid = -1; return; }
        hipOccupancyMaxActiveBlocksPerMultiprocessor(&per_cu, (const void*)yoco_fwd, NTHREADS, LDS_BYTES);
        (void)hipGetLastError();
        if (per_cu < 1) fprintf(stderr, "kernel_launch: occupancy query reports %d blocks per CU\n", per_cu);
        grid = cus > 0 ? cus : 256;
    }
    if (grid < 0) return;
    Params p{};
    p.x = (const float*)d_in[0]; p.pool_w = (const float*)d_in[1]; p.pool_scale = (const float*)d_in[2]; p.w_q = (const float*)d_in[3]; p.w_kv = (const float*)d_in[4];
    p.w_o = (const float*)d_in[5]; p.w_gate = (const float*)d_in[6]; p.w_up = (const float*)d_in[7]; p.conv_w = (const float*)d_in[8]; p.conv_b = (const float*)d_in[9];
    p.w_down = (const float*)d_in[10]; p.ln1_g = (const float*)d_in[11]; p.ln1_b = (const float*)d_in[12]; p.ln2_g = (const float*)d_in[13]; p.ln2_b = (const float*)d_in[14];
    p.out = (float*)d_out; p.ws = (unsigned char*)d_ws;
    for (int i = 0; i < 32; ++i) p.inv_freq[i] = pow(10000.0, -(double)(2 * i) / 64.0);
    p.ph_lo = 0; p.ph_hi = 1000;
    if (hipMemsetAsync((unsigned char*)d_ws + WS_BAR, 0, XCD_BAR_WORDS * 4, stream) != hipSuccess) { fprintf(stderr, "kernel_launch: memset of the barrier words failed\n"); return; }
    void* args[] = {&p};
    hipError_t e = hipLaunchCooperativeKernel((const void*)yoco_fwd, dim3(grid), dim3(NTHREADS), args, LDS_BYTES, stream);
    if (e != hipSuccess) fprintf(stderr, "kernel_launch: cooperative launch failed: %s (grid %d)\n", hipGetErrorString(e), grid);
}
```

```cpp
#include <hip/hip_runtime.h>
#include <hip/hip_cooperative_groups.h>
#include <cstdio>
#include <cstdint>
#include <cmath>
namespace cg = cooperative_groups;
namespace pg8 {
#define PG8_LAS __attribute__((address_space(3)))
typedef unsigned short bf16_t;
typedef short bf16x8 __attribute__((ext_vector_type(8)));
typedef float f32x4 __attribute__((ext_vector_type(4)));
typedef unsigned u32x4 __attribute__((ext_vector_type(4)));
constexpr int BM = 256, BK = 64, HALF = 128, HTB = HALF * BK * 2  , STAGE_BYTES = 8 * HTB, NXCD = 8, WGM = 8;

__host__ __device__ __forceinline__ int lds_byte(int r, int c) { const int st = (r >> 4) * 2 + (c >> 5), rr = r & 15, cc = c & 31, ob = rr * 64 + cc * 2; return st * 1024 + (ob ^ (((ob >> 9) & 1) << 5)); }
__host__ __device__ __forceinline__ void stage_rc(int b, int& R, int& C) { const int st = b / 1024, sb = b % 1024, swz = sb ^ (((sb >> 9) & 1) << 5); R = (st >> 1) * 16 + swz / 64; C = (st & 1) * 32 + (swz % 64) / 2; }
__host__ __device__ __forceinline__ int perm32(int rho) { const int n = rho >> 4, i = rho & 15; return 8 * (i >> 2) + 4 * n + (i & 3); }

struct Unit { int pm, pn; };
struct Gemm { const bf16_t* A; const bf16_t* Bt; int M, N, K; };

struct StaticOrder {
    int nM, nN, nwg, G, c;
    __host__ __device__ void init(int M, int N, int G_, int c_) { nM = M / BM; nN = N / BM; nwg = nM * nN; G = G_; c = c_; }
    __host__ __device__ bool next(int i, Unit& u) const {
        const long L = (long)i * G + c; if (L >= nwg) return false;
        int wgid = (int)L; { const int q = nwg / NXCD, r = nwg % NXCD, xcd = wgid % NXCD, off = wgid / NXCD; wgid = (xcd < r ? xcd * (q + 1) : r * (q + 1) + (xcd - r) * q) + off; }
        const int nig = WGM * nN, gid = wgid / nig, fm = gid * WGM, gsz = (nM - fm) < WGM ? (nM - fm) : WGM;
        u.pm = fm + ((wgid % nig) % gsz); u.pn = (wgid % nig) / gsz; return true;
    }
    __device__ __forceinline__ void a_ready(const Unit&) const {}
    __device__ __forceinline__ void done(const Unit&) const {}
};

__device__ __forceinline__ unsigned cvt_pk_bf16(float lo, float hi) { unsigned r; asm volatile("v_cvt_pk_bf16_f32 %0, %1, %2" : "=v"(r) : "v"(lo), "v"(hi)); return r; }
template <class Epi, class Sched, bool ALIGN_EPI = false, bool SP2 = false>
__device__ __forceinline__ void gemm_phase(PG8_LAS unsigned char* lds, const Gemm g, const Sched& S, const Epi& E, int tid_in) {
    int tid_ = tid_in; asm volatile("" : "+v"(tid_)); const int tid = tid_, wid = __builtin_amdgcn_readfirstlane(tid >> 6), lane = tid & 63, wr = wid >> 2, wc = wid & 3, fr = lane & 15, fq = lane >> 4;
    const int K = g.K, nt = K / BK;
    unsigned voffA[2], voffB[2];
#pragma unroll
    for (int i = 0; i < 2; ++i) { int R, C; stage_rc(tid * 16 + i * 8192, R, C); const int Rb = Epi::bmap(Epi::PERM ? ((R & ~31) + perm32(R & 31)) : R);
        voffA[i] = (unsigned)(Epi::amap(R) * K + C) * 2u; voffB[i] = (unsigned)(Rb * K + C) * 2u; }
    const size_t kstep = (size_t)(BK * 2);
    const size_t hstep = (size_t)HALF * K * 2;
    const size_t tstep = 2 * hstep;
    const unsigned ldsw = (unsigned)wid * 1024u;
    const int aoff = lds_byte(wr * 64 + fr, fq * 8), boff = lds_byte(wc * 32 + fr, fq * 8);
#define PG8_SA(b, h) (((b) * 2 + (h)) * HTB)
#define PG8_SB(b, h) ((4 + (b) * 2 + (h)) * HTB)
#define PG8_STAGE(bufoff, gbase, voff) do { _Pragma("unroll") for (int _i = 0; _i < 2; ++_i) \
        __builtin_amdgcn_global_load_lds((const unsigned*)((const char*)(gbase) + (voff)[_i]), (PG8_LAS unsigned*)(lds + (bufoff) + ldsw + _i * 8192), 16, 0, 0); } while (0)
#define PG8_LDA(dst, b, h) do { _Pragma("unroll") for (int m = 0; m < 4; ++m) _Pragma("unroll") for (int k = 0; k < 2; ++k) dst[m][k] = *(const PG8_LAS bf16x8*)(lds + PG8_SA(b, h) + aoff + m * 2048 + k * 1024); } while (0)
#define PG8_LDB(dst, b, h) do { _Pragma("unroll") for (int n = 0; n < 2; ++n) _Pragma("unroll") for (int k = 0; k < 2; ++k) dst[n][k] = *(const PG8_LAS bf16x8*)(lds + PG8_SB(b, h) + boff + n * 2048 + k * 1024); } while (0)
#define PG8_MMA(ai, bj, At, Bt) do { __builtin_amdgcn_s_setprio(1); _Pragma("unroll") for (int m = 0; m < 4; ++m) _Pragma("unroll") for (int n = 0; n < 2; ++n) _Pragma("unroll") for (int k = 0; k < 2; ++k) \
        acc[ai][bj][m][n] = __builtin_amdgcn_mfma_f32_16x16x32_bf16(Bt[n][k], At[m][k], acc[ai][bj][m][n], 0, 0, 0); __builtin_amdgcn_s_setprio(0); } while (0)
#define PG8_WAIT_V(n) asm volatile("s_waitcnt vmcnt(" #n ")" ::: "memory")
#define PG8_WAIT_L(n) asm volatile("s_waitcnt lgkmcnt(" #n ")" ::: "memory")
#define PG8_BAR __builtin_amdgcn_s_barrier()
#define PG8_SCHED __builtin_amdgcn_sched_barrier(0)
    Unit cur, nxt; int ui = 0;
    if (!S.next(0, cur)) return;
    f32x4 acc[2][2][4][2];
#pragma unroll
    for (int a = 0; a < 2; ++a)
#pragma unroll
        for (int b = 0; b < 2; ++b)
#pragma unroll
            for (int m = 0; m < 4; ++m)
#pragma unroll
                for (int n = 0; n < 2; ++n) acc[a][b][m][n] = (f32x4){0.f, 0.f, 0.f, 0.f};
    bf16x8 At[4][2], B0[2][2], B1[2][2];
    const char* cA = (const char*)g.A + (size_t)cur.pm * tstep; const char* cB = (const char*)g.Bt + (size_t)cur.pn * tstep;
    S.a_ready(cur);
    if constexpr (SP2) {
        PG8_STAGE(PG8_SB(0, 0), cB, voffB); PG8_STAGE(PG8_SB(0, 1), cB + hstep, voffB); PG8_STAGE(PG8_SA(0, 0), cA, voffA); PG8_STAGE(PG8_SA(0, 1), cA + hstep, voffA);
        if (wr == 1) PG8_BAR;
        PG8_WAIT_V(2); PG8_BAR;
        PG8_STAGE(PG8_SB(1, 0), cB + kstep, voffB); PG8_STAGE(PG8_SA(1, 0), cA + kstep, voffA); PG8_STAGE(PG8_SB(1, 1), cB + hstep + kstep, voffB);
        PG8_WAIT_V(6); PG8_BAR;
    } else {
        PG8_STAGE(PG8_SB(0, 0), cB, voffB); PG8_STAGE(PG8_SA(0, 0), cA, voffA); PG8_STAGE(PG8_SB(0, 1), cB + hstep, voffB); PG8_STAGE(PG8_SA(0, 1), cA + hstep, voffA);
        if (wr == 1) PG8_BAR;
        PG8_WAIT_V(4); PG8_BAR;
        PG8_STAGE(PG8_SB(1, 0), cB + kstep, voffB); PG8_STAGE(PG8_SA(1, 0), cA + kstep, voffA); PG8_STAGE(PG8_SB(1, 1), cB + hstep + kstep, voffB);
        PG8_WAIT_V(6); PG8_BAR;
    }
    for (;;) {
        const bool has_next = S.next(ui + 1, nxt);
        const char* nA = has_next ? (const char*)g.A + (size_t)nxt.pm * tstep : cA; const char* nB = has_next ? (const char*)g.Bt + (size_t)nxt.pn * tstep : cB;
        for (int t = 0; t < nt; t += 2) {
            const bool last = (t == nt - 2);
            const char* a1 = cA + (size_t)(t + 1) * kstep;
            const char* a2 = last ? nA : cA + (size_t)(t + 2) * kstep; const char* b2 = last ? nB : cB + (size_t)(t + 2) * kstep;
            const char* a3 = a2 + kstep; const char* b3 = b2 + kstep;
            if (last && has_next) S.a_ready(nxt);
            if constexpr (SP2) {
            PG8_LDB(B0, 0, 0); PG8_LDB(B1, 0, 1); PG8_SCHED; PG8_LDA(At, 0, 0); PG8_STAGE(PG8_SA(1, 1), a1 + hstep, voffA);
            PG8_WAIT_V(8); PG8_WAIT_L(0); PG8_BAR; PG8_MMA(0, 0, At, B0); PG8_MMA(0, 1, At, B1); PG8_BAR; PG8_SCHED;
            PG8_LDA(At, 0, 1); PG8_STAGE(PG8_SB(0, 0), b2, voffB); PG8_STAGE(PG8_SB(0, 1), b2 + hstep, voffB); PG8_STAGE(PG8_SA(0, 0), a2, voffA);
            PG8_WAIT_V(8); PG8_WAIT_L(0); PG8_BAR; PG8_MMA(1, 0, At, B0); PG8_MMA(1, 1, At, B1); PG8_BAR; PG8_SCHED;
            PG8_LDB(B0, 1, 0); PG8_LDB(B1, 1, 1); PG8_SCHED; PG8_LDA(At, 1, 0); PG8_STAGE(PG8_SA(0, 1), a2 + hstep, voffA);
            PG8_WAIT_V(8); PG8_WAIT_L(0); PG8_BAR; PG8_MMA(0, 0, At, B0); PG8_MMA(0, 1, At, B1); PG8_BAR; PG8_SCHED;
            PG8_LDA(At, 1, 1); PG8_STAGE(PG8_SB(1, 0), b3, voffB); PG8_STAGE(PG8_SB(1, 1), b3 + hstep, voffB); PG8_STAGE(PG8_SA(1, 0), a3, voffA);
            PG8_WAIT_V(8); PG8_WAIT_L(0); PG8_BAR; PG8_MMA(1, 0, At, B0); PG8_MMA(1, 1, At, B1); PG8_BAR; PG8_SCHED;
            } else {
            PG8_LDB(B0, 0, 0); PG8_SCHED; PG8_LDA(At, 0, 0); PG8_STAGE(PG8_SA(1, 1), a1 + hstep, voffA);
            PG8_WAIT_L(8); PG8_BAR; PG8_WAIT_L(0); PG8_MMA(0, 0, At, B0); PG8_BAR; PG8_SCHED;
            PG8_LDB(B1, 0, 1); PG8_STAGE(PG8_SB(0, 0), b2, voffB);
            PG8_BAR; PG8_WAIT_L(0); PG8_MMA(0, 1, At, B1); PG8_BAR;
            PG8_LDA(At, 0, 1); PG8_STAGE(PG8_SA(0, 0), a2, voffA);
            PG8_BAR; PG8_WAIT_L(0); PG8_MMA(1, 0, At, B0); PG8_BAR; PG8_SCHED;
            PG8_STAGE(PG8_SB(0, 1), b2 + hstep, voffB);
            PG8_WAIT_V(6); PG8_BAR; PG8_MMA(1, 1, At, B1); PG8_BAR;
            PG8_LDB(B0, 1, 0); PG8_SCHED; PG8_LDA(At, 1, 0); PG8_STAGE(PG8_SA(0, 1), a2 + hstep, voffA);
            PG8_WAIT_L(8); PG8_BAR; PG8_WAIT_L(0); PG8_MMA(0, 0, At, B0); PG8_BAR; PG8_SCHED;
            PG8_LDB(B1, 1, 1); PG8_STAGE(PG8_SB(1, 0), b3, voffB);
            PG8_BAR; PG8_WAIT_L(0); PG8_MMA(0, 1, At, B1); PG8_BAR;
            PG8_LDA(At, 1, 1); PG8_STAGE(PG8_SA(1, 0), a3, voffA);
            PG8_BAR; PG8_WAIT_L(0); PG8_MMA(1, 0, At, B0); PG8_BAR; PG8_SCHED;
            PG8_STAGE(PG8_SB(1, 1), b3 + hstep, voffB);
            PG8_WAIT_V(6); PG8_BAR; PG8_MMA(1, 1, At, B1); PG8_BAR;
            }
        }
        if constexpr (ALIGN_EPI) { if (wr == 0) PG8_BAR; }
        if constexpr (!Epi::AFTER_DRAIN) { E(acc, cur, wr, wc, fr, fq); S.done(cur); }
        if (!has_next) break;
#pragma unroll
        for (int a = 0; a < 2; ++a)
#pragma unroll
            for (int b = 0; b < 2; ++b)
#pragma unroll
                for (int m = 0; m < 4; ++m)
#pragma unroll
                    for (int n = 0; n < 2; ++n) acc[a][b][m][n] = (f32x4){0.f, 0.f, 0.f, 0.f};
        cur = nxt; cA = nA; cB = nB; ++ui;
        if constexpr (ALIGN_EPI) { if (wr == 1) PG8_BAR; }
    }
    PG8_WAIT_V(0);
    if constexpr (!ALIGN_EPI) { if (wr == 0) PG8_BAR; }
    PG8_BAR;
    if constexpr (Epi::AFTER_DRAIN) { E.fused(acc, cur, wr, wc, fr, fq, lds, wid, lane); S.done(cur); }
#undef PG8_SA
#undef PG8_SB
#undef PG8_STAGE
#undef PG8_LDA
#undef PG8_LDB
#undef PG8_MMA
#undef PG8_WAIT_V
#undef PG8_WAIT_L
#undef PG8_BAR
#undef PG8_SCHED
}
}

#define LAS __attribute__((address_space(3)))
typedef unsigned short bf16;
typedef float f32x4 __attribute__((ext_vector_type(4)));
typedef float f32x16 __attribute__((ext_vector_type(16)));
typedef short bf16x8 __attribute__((ext_vector_type(8)));
typedef unsigned u32x4 __attribute__((ext_vector_type(4)));
typedef unsigned u32x2 __attribute__((ext_vector_type(2)));
typedef __bf16 bf16x2_t __attribute__((ext_vector_type(2)));
typedef float f32x2_t __attribute__((ext_vector_type(2)));

constexpr int DM = 1024, SEQ = 2048, MTOK = 65536, DFF = 2816, QD = 3072;
constexpr int MH = 32768;
constexpr float ALPHA = 1.6817928305074290f;
constexpr float LN_EPS = 1e-5f;
constexpr float QSCALE = 0.125f * 1.4426950408889634f;
constexpr int NTHREADS = 512, NWAVES = 8;
constexpr int LDS_BYTES = 131072 + 1024;

constexpr size_t MiB = 1u << 20;
constexpr size_t WS_WPOOL = 0;
constexpr size_t WS_WGU = 1 * MiB;
constexpr size_t WS_WDOWN = 45 * MiB;
constexpr size_t WS_WQ = 67 * MiB;
constexpr size_t WS_WK = 79 * MiB;
constexpr size_t WS_WV = 85 * MiB;
constexpr size_t WS_WO = 91 * MiB;
constexpr size_t WS_ROPE = 95 * MiB;
constexpr size_t WS_BAR = 95 * MiB + 768 * 1024;
constexpr size_t WS_XB = 96 * MiB;
constexpr size_t WS_GS = 224 * MiB;
constexpr size_t WS_US = 268 * MiB;
constexpr size_t WS_LSE = 290 * MiB;
constexpr size_t WS_ATT = 296 * MiB;
constexpr size_t WS_H = 360 * MiB;
constexpr size_t WS_K = 552 * MiB;
constexpr size_t WS_V = 744 * MiB;
constexpr size_t WS_FA = 712 * MiB;
constexpr size_t WS_STATS = 936 * MiB;
constexpr size_t WS_END = 937 * MiB;

struct Params {
    const float* x; const float* pool_w; const float* pool_scale; const float* w_q; const float* w_kv; const float* w_o;
    const float* w_gate; const float* w_up; const float* conv_w; const float* conv_b; const float* w_down;
    const float* ln1_g; const float* ln1_b; const float* ln2_g; const float* ln2_b;
    float* out; unsigned char* ws;
    double inv_freq[32];
    int ph_lo, ph_hi;
};

__device__ __forceinline__ unsigned pk2(float lo, float hi) { f32x2_t v = {lo, hi}; bf16x2_t b = __builtin_convertvector(v, bf16x2_t); return __builtin_bit_cast(unsigned, b); }
__device__ __forceinline__ float bflo(unsigned w) { return __builtin_bit_cast(float, w << 16); }
__device__ __forceinline__ float bfhi(unsigned w) { return __builtin_bit_cast(float, w & 0xffff0000u); }
__device__ __forceinline__ float shfl_xor_l(float v, int mask, int lane) { return __builtin_bit_cast(float, __builtin_amdgcn_ds_bpermute((lane ^ mask) << 2, __builtin_bit_cast(int, v))); }
__device__ __forceinline__ float wave_sum(float v, int lane) {
#pragma unroll
    for (int o = 1; o < 64; o <<= 1) v += shfl_xor_l(v, o, lane);
    return v;
}
__device__ __forceinline__ float gelu_tanh(float x) {
    const float e = __builtin_amdgcn_exp2f(x * (-2.3022081985f + -0.1029432392f * x * x));
    return x * __builtin_amdgcn_rcpf(1.0f + e);
}

using pg8::Unit;
struct EpiF {
    static constexpr bool PERM = true, AFTER_DRAIN = false; static constexpr int REPS = 1;
    static __host__ __device__ __forceinline__ int bmap(int r) { return r; }
    static __host__ __device__ __forceinline__ int amap(int r) { return r; }
    bf16* F; const float* scale; bool pool;
    __device__ __forceinline__ void operator()(const f32x4 (&acc)[2][2][4][2], const Unit& u, int wr, int wc, int fr, int fq) const {
        int fr_ = fr, fq_ = fq; asm volatile("" : "+v"(fr_), "+v"(fq_));
        const int row0 = (pool ? (u.pm >> 2) : u.pm) * 256 + wr * 64 + fr_, col0 = u.pn * 256 + wc * 32 + 8 * fq_;
#pragma unroll
        for (int bj = 0; bj < 2; ++bj) {
            f32x4 s0 = {1.f, 1.f, 1.f, 1.f}, s1 = {1.f, 1.f, 1.f, 1.f};
            if (scale) { s0 = *(const f32x4*)(scale + col0 + bj * 128); s1 = *(const f32x4*)(scale + col0 + bj * 128 + 4); }
#pragma unroll
            for (int ai = 0; ai < 2; ++ai)
#pragma unroll
                for (int m = 0; m < 4; ++m) {
                    const f32x4 v0 = acc[ai][bj][m][0] * s0, v1 = acc[ai][bj][m][1] * s1;
                    u32x4 w; w.x = pk2(v0[0], v0[1]); w.y = pk2(v0[2], v0[3]); w.z = pk2(v1[0], v1[1]); w.w = pk2(v1[2], v1[3]);
                    *(u32x4*)(F + (size_t)(row0 + ai * 128 + m * 16) * DM + col0 + bj * 128) = w;
                }
        }
    }
};
struct EpiGU {
    static constexpr bool PERM = true, AFTER_DRAIN = false; static constexpr int REPS = 1;
    static __host__ __device__ __forceinline__ int bmap(int r) { return r; }
    static __host__ __device__ __forceinline__ int amap(int r) { return (r & 64) + 4 * (r & 15) + ((r >> 4) & 3); }
    bf16* H; float* GS; float* US; const float* cw; const float* cb;
    __device__ __forceinline__ void operator()(const f32x4 (&acc)[2][2][4][2], const Unit& u, int wr, int wc, int fr, int fq) const {
        const int colbase = u.pn * 128 + wc * 32 + fq * 8;
        f32x4 cwv[2][4];
#pragma unroll
        for (int n = 0; n < 2; ++n) { const int col = colbase + 4 * n;
            cwv[n][0] = *(const f32x4*)(cw + col); cwv[n][1] = *(const f32x4*)(cw + DFF + col); cwv[n][2] = *(const f32x4*)(cw + 2 * DFF + col); cwv[n][3] = *(const f32x4*)(cb + col); }
        const f32x4 k1 = {-0.1029432392f, -0.1029432392f, -0.1029432392f, -0.1029432392f}, k0 = {-2.3022081985f, -2.3022081985f, -2.3022081985f, -2.3022081985f};
#pragma unroll
        for (int ai = 0; ai < 2; ++ai) {
            const int strip = u.pm * 4 + ai * 2 + wr;
            u32x4 w[4];
#pragma unroll
            for (int n = 0; n < 2; ++n) {
                const int col = colbase + 4 * n;
                f32x4 s2, s3;
#pragma unroll
                for (int j = 0; j < 4; ++j)
                    asm("s_nop 1\n\tv_mov_b32_dpp %0, %2 row_shr:1 row_mask:0xf bank_mask:0xf bound_ctrl:0\n\tv_mov_b32_dpp %1, %3 row_shr:1 row_mask:0xf bank_mask:0xf bound_ctrl:0"
                        : "=&v"(s2[j]), "=&v"(s3[j]) : "v"(acc[ai][0][2][n][j]), "v"(acc[ai][0][3][n][j]));
#pragma unroll
                for (int m = 0; m < 4; ++m) {
                    const f32x4 g = acc[ai][0][m][n], up = acc[ai][1][m][n];
                    const f32x4 p1 = (m == 0) ? s3 : acc[ai][0][m == 0 ? 0 : m - 1][n];
                    const f32x4 p2 = (m == 0) ? s2 : ((m == 1) ? s3 : acc[ai][0][m < 2 ? 0 : m - 2][n]);
                    const f32x4 cv = __builtin_elementwise_fma(cwv[n][2], g, __builtin_elementwise_fma(cwv[n][1], p1, __builtin_elementwise_fma(cwv[n][0], p2, cwv[n][3])));
                    const f32x4 arg = cv * __builtin_elementwise_fma(cv * cv, k1, k0);
                    f32x4 den;
#pragma unroll
                    for (int j = 0; j < 4; ++j) den[j] = __builtin_amdgcn_rcpf(1.0f + __builtin_amdgcn_exp2f(arg[j]));
                    const f32x4 hv = (cv * up) * den;
                    if (n == 0) { w[m].x = pk2(hv[0], hv[1]); w[m].y = pk2(hv[2], hv[3]); } else { w[m].z = pk2(hv[0], hv[1]); w[m].w = pk2(hv[2], hv[3]); }
                    if (m < 2 && fr == 0) { *(f32x4*)(GS + (size_t)(strip * 4 + 2 + m) * DFF + col) = g; *(f32x4*)(US + (size_t)(strip * 2 + m) * DFF + col) = up; }
                    if (m >= 2 && fr == 15) { *(f32x4*)(GS + (size_t)(strip * 4 + (m - 2)) * DFF + col) = g; }
                }
            }
            const int row0 = u.pm * 256 + ai * 128 + wr * 64 + 4 * fr;
#pragma unroll
            for (int m = 0; m < 4; ++m) *(u32x4*)(H + (size_t)(row0 + m) * DFF + colbase) = w[m];
        }
    }
};
struct EpiRope {
    static constexpr bool PERM = true, AFTER_DRAIN = false; static constexpr int REPS = 1;
    static __host__ __device__ __forceinline__ int bmap(int r) { return r; }
    static __host__ __device__ __forceinline__ int amap(int r) { return r; }
    bf16* O; const float* cosT; const float* sinT; float scale;
    __device__ __forceinline__ void operator()(const f32x4 (&acc)[2][2][4][2], const Unit& u, int wr, int wc, int fr, int fq) const {
        const int a4 = 4 * (4 * (wc & 1) + fq);
#pragma unroll
        for (int ai = 0; ai < 2; ++ai)
#pragma unroll
            for (int m = 0; m < 4; ++m) {
                const int tl = u.pm * 256 + ai * 128 + wr * 64 + m * 16 + fr;
                const int b = tl >> 11, t = tl & 2047;
                const f32x4 c4 = *(const f32x4*)(cosT + t * 32 + a4), s4 = *(const f32x4*)(sinT + t * 32 + a4);
#pragma unroll
                for (int bj = 0; bj < 2; ++bj) {
                    const int col = u.pn * 256 + bj * 128 + wc * 32 + fq * 8;
                    const int g = col >> 10, h = (col >> 6) & 15, p0 = col & 63, dsh = 2 * g;
                    const int pos = ((t & ((1 << dsh) - 1)) << (11 - dsh)) + (t >> dsh);
                    const f32x4 x1 = acc[ai][bj][m][0], x2 = acc[ai][bj][m][1];
                    const f32x4 o1 = (x1 * c4 - x2 * s4) * scale, o2 = (x2 * c4 + x1 * s4) * scale;
                    u32x4 w; w.x = pk2(o1[0], o1[1]); w.y = pk2(o1[2], o1[3]); w.z = pk2(o2[0], o2[1]); w.w = pk2(o2[2], o2[3]);
                    *(u32x4*)(O + ((size_t)((g * 16 + b) * 16 + h) * 2048 + pos) * 64 + p0) = w;
                }
            }
    }
};
template <int G> struct EpiVt {
    static constexpr bool PERM = true, AFTER_DRAIN = false; static constexpr int REPS = 1;
    static __host__ __device__ __forceinline__ int bmap(int c) { return G == 0 ? c : (G == 1 ? (4 * (c & 31) + (c >> 5)) : (16 * (c & 7) + (c >> 3))); }
    static __host__ __device__ __forceinline__ int amap(int r) { return r; }
    bf16* V;
    __device__ __forceinline__ void operator()(const f32x4 (&acc)[2][2][4][2], const Unit& u, int wr, int wc, int fr, int fq) const {
        constexpr int L = 2048 >> (2 * G);
        const int b = u.pn >> 3, tis = u.pn & 7;
#pragma unroll
        for (int ai = 0; ai < 2; ++ai)
#pragma unroll
            for (int m = 0; m < 4; ++m) {
                const int vr = u.pm * 256 + ai * 128 + wr * 64 + m * 16 + fr;
                bf16* base = V + (size_t)((G * 16 + b) * 16 + (vr >> 6)) * (2048 * 64) + (size_t)(vr & 63) * L;
#pragma unroll
                for (int bj = 0; bj < 2; ++bj) {
                    int r, mi;
                    if (G == 0) { r = 0; mi = 256 * tis + bj * 128 + wc * 32 + fq * 8; } else if (G == 1) { r = wc; mi = 64 * tis + 32 * bj + fq * 8; } else { r = wc * 4 + fq; mi = 16 * tis + 8 * bj; }
                    const f32x4 v0 = acc[ai][bj][m][0], v1 = acc[ai][bj][m][1];
                    u32x4 w; w.x = pk2(v0[0], v0[1]); w.y = pk2(v0[2], v0[3]); w.z = pk2(v1[0], v1[1]); w.w = pk2(v1[2], v1[3]);
                    *(u32x4*)(base + (size_t)r * 64 * L + mi) = w;
                }
            }
    }
};
struct PoolOrder {
    int G, c, ntiles;
    __device__ bool next(int i, Unit& u) const { const int tile = c + G * (i >> 2); if (tile >= ntiles) return false; u.pm = tile * 4 + (i & 3); u.pn = i & 3; return true; }
    __device__ __forceinline__ void a_ready(const Unit&) const {}
    __device__ __forceinline__ void done(const Unit&) const {}
};

template <class Map>
__device__ __forceinline__ void transpose_w(int K, int N, int ldw, bf16* Wt, const Map& cmap, LAS float* scr, int gw, int ngw, int lane) {
    const int nblk = N / 32, items = (K / 64) * nblk;
    for (int it = gw; it < items; it += ngw) {
        const int kb = it / nblk, nb = it % nblk, k0 = 64 * kb, n0 = 32 * nb;
        const float* src = cmap(n0 + (lane & 31)) + (size_t)(k0 + (lane >> 5)) * ldw;
#pragma unroll 8
        for (int i = 0; i < 32; ++i) scr[(2 * i + (lane >> 5)) * 33 + (lane & 31)] = src[(size_t)(2 * i) * ldw];
        asm volatile("s_waitcnt lgkmcnt(0)" ::: "memory");
        const int c = lane & 7;
#pragma unroll
        for (int j = 0; j < 4; ++j) {
            const int n = (lane >> 3) + 8 * j; const LAS float* s = scr + (8 * c) * 33 + n;
            u32x4 o; o.x = pk2(s[0], s[33]); o.y = pk2(s[2 * 33], s[3 * 33]); o.z = pk2(s[4 * 33], s[5 * 33]); o.w = pk2(s[6 * 33], s[7 * 33]);
            *(u32x4*)(Wt + (size_t)(n0 + n) * K + k0 + 8 * c) = o;
        }
        asm volatile("s_waitcnt lgkmcnt(0)" ::: "memory");
    }
}
struct MapGen { int type; const float* W; const float* W2;
    __device__ __forceinline__ const float* operator()(int n) const {
        if (type == 0) return W + n;
        if (type == 1) { const int p = n & 63; const int dsrc = (p & 4) ? (32 + 4 * (p >> 3) + (p & 3)) : (4 * (p >> 3) + (p & 3)); return W + (n & ~63) + dsrc; }
        const int pn = n >> 8, q = n & 255; return (q < 128) ? (W + pn * 128 + q) : (W2 + pn * 128 + q - 128);
    } };
template <class PT> __device__ __forceinline__ void prep_phase(const PT& p, LAS unsigned char* lds, int gw, int ngw, int lane, int wave) {
    LAS float* scr = (LAS float*)(lds + wave * 16384);
    unsigned char* ws = p.ws;
    for (int mi = 0; mi < 22; ++mi) {
        int K, N, ldw; bf16* Wt; MapGen mp; mp.W2 = nullptr;
        if (mi < 8) { K = 256; N = 256; ldw = 256; Wt = (bf16*)(ws + WS_WPOOL) + (size_t)mi * 65536; mp.type = 0; mp.W = p.pool_w + (size_t)mi * 65536; }
        else if (mi < 12) { const int l = mi - 8; K = DM; N = 2 * DFF; ldw = DFF; Wt = (bf16*)(ws + WS_WGU) + (size_t)l * 2 * DFF * DM; mp.type = 2; mp.W = p.w_gate + (size_t)l * DM * DFF; mp.W2 = p.w_up + (size_t)l * DM * DFF; }
        else if (mi < 16) { const int l = mi - 12; K = DFF; N = DM; ldw = DM; Wt = (bf16*)(ws + WS_WDOWN) + (size_t)l * DM * DFF; mp.type = 0; mp.W = p.w_down + (size_t)l * DFF * DM; }
        else if (mi < 18) { const int j = mi - 16; K = DM; N = QD; ldw = QD; Wt = (bf16*)(ws + WS_WQ) + (size_t)j * QD * DM; mp.type = 1; mp.W = p.w_q + (size_t)j * DM * QD; }
        else if (mi < 20) { const int j = mi - 18; K = DM; N = DM; ldw = DM; Wt = (bf16*)(ws + WS_WO) + (size_t)j * DM * DM; mp.type = 0; mp.W = p.w_o + (size_t)j * DM * DM; }
        else if (mi == 20) { K = DM; N = QD; ldw = 2 * QD; Wt = (bf16*)(ws + WS_WK); mp.type = 1; mp.W = p.w_kv; }
        else { K = DM; N = QD; ldw = 2 * QD; Wt = (bf16*)(ws + WS_WV); mp.type = 0; mp.W = p.w_kv + QD; }
        transpose_w(K, N, ldw, Wt, mp, scr, gw, ngw, lane);
    }
    float* cosT = (float*)(ws + WS_ROPE); float* sinT = cosT + SEQ * 32;
    for (int i = gw * 64 + lane; i < SEQ * 32; i += ngw * 64) {
        const int t = i >> 5, f = i & 31;
        const double rev = (double)t * p.inv_freq[f] * 0.15915494309189535;
        const float fr = (float)(rev - rint(rev));
        cosT[i] = __builtin_amdgcn_cosf(fr); sinT[i] = __builtin_amdgcn_sinf(fr);
    }
}

__device__ __forceinline__ void pool_phase(const float* xin, bf16* PA, int gtid, int nthr) {
    for (int idx = gtid; idx < (MTOK / 32) * 128; idx += nthr) {
        const int run = idx >> 7, rem = idx & 127, g = rem >> 5, ch = rem & 31;
        const int w = 2 << g, ts = run * 32, pos0 = ts & 2047;
        const float* px = xin + (size_t)ts * DM + g * 256 + ch * 8;
        f32x4 s0 = {0.f, 0.f, 0.f, 0.f}, s1 = {0.f, 0.f, 0.f, 0.f};
        const int nb = (pos0 < w) ? pos0 : w;
        for (int j = 1; j <= nb; ++j) { s0 += *(const f32x4*)(px - (size_t)j * DM); s1 += *(const f32x4*)(px - (size_t)j * DM + 4); }
        bf16* po = PA + ((size_t)((ts >> 8) * 4 + g) * 256 + (ts & 255)) * 256 + ch * 8;
#pragma unroll 4
        for (int i = 0; i < 32; ++i) {
            const int pos = pos0 + i;
            const f32x4 x0 = *(const f32x4*)(px + (size_t)i * DM), x1 = *(const f32x4*)(px + (size_t)i * DM + 4);
            s0 += x0; s1 += x1;
            if (pos >= w) { s0 -= *(const f32x4*)(px + (size_t)(i - w) * DM); s1 -= *(const f32x4*)(px + (size_t)(i - w) * DM + 4); }
            const float ic = 1.0f / (float)((pos + 1 < w) ? (pos + 1) : w);
            const f32x4 a0 = s0 * ic - x0, a1 = s1 * ic - x1;
            u32x4 o; o.x = pk2(a0[0], a0[1]); o.y = pk2(a0[2], a0[3]); o.z = pk2(a1[0], a1[1]); o.w = pk2(a1[2], a1[3]);
            *(u32x4*)(po + (size_t)i * 256) = o;
        }
    }
}
__device__ __forceinline__ void wave_sum2(float& a, float& b, int lane) {
    float t, u;
    asm("s_nop 1\n\tv_add_f32_dpp %0, %2, %2 quad_perm:[1,0,3,2] row_mask:0xf bank_mask:0xf\n\tv_add_f32_dpp %1, %3, %3 quad_perm:[1,0,3,2] row_mask:0xf bank_mask:0xf" : "=&v"(t), "=&v"(u) : "v"(a), "v"(b));
    asm("s_nop 1\n\tv_add_f32_dpp %0, %2, %2 quad_perm:[2,3,0,1] row_mask:0xf bank_mask:0xf\n\tv_add_f32_dpp %1, %3, %3 quad_perm:[2,3,0,1] row_mask:0xf bank_mask:0xf" : "=&v"(a), "=&v"(b) : "v"(t), "v"(u));
    asm("s_nop 1\n\tv_add_f32_dpp %0, %2, %2 row_half_mirror row_mask:0xf bank_mask:0xf\n\tv_add_f32_dpp %1, %3, %3 row_half_mirror row_mask:0xf bank_mask:0xf" : "=&v"(t), "=&v"(u) : "v"(a), "v"(b));
    asm("s_nop 1\n\tv_add_f32_dpp %0, %2, %2 row_mirror row_mask:0xf bank_mask:0xf\n\tv_add_f32_dpp %1, %3, %3 row_mirror row_mask:0xf bank_mask:0xf" : "=&v"(a), "=&v"(b) : "v"(t), "v"(u));
    a += shfl_xor_l(a, 16, lane); b += shfl_xor_l(b, 16, lane);
    a += shfl_xor_l(a, 32, lane); b += shfl_xor_l(b, 32, lane);
}
__device__ __forceinline__ float fp8lo(unsigned w, int k) { return k == 0 ? __builtin_amdgcn_cvt_f32_fp8((int)w, 0) : k == 1 ? __builtin_amdgcn_cvt_f32_fp8((int)w, 1) : k == 2 ? __builtin_amdgcn_cvt_f32_fp8((int)w, 2) : __builtin_amdgcn_cvt_f32_fp8((int)w, 3); }
template <bool IN_SPLIT, bool OUT_SPLIT>
__device__ __forceinline__ void addln_phase(const float* base, float* S, const bf16* F, bf16* XB, const float* gB, const float* bB, int nrows, int gw, int ngw, int lane) {
    f32x4 gb[4], bb[4];
#pragma unroll
    for (int j = 0; j < 2; ++j)
#pragma unroll
        for (int h = 0; h < 2; ++h) { gb[2 * j + h] = *(const f32x4*)(gB + 8 * lane + 512 * j + 4 * h); bb[2 * j + h] = *(const f32x4*)(bB + 8 * lane + 512 * j + 4 * h); }
    u32x4 fw[2], hw[2]; u32x2 lw[2]; f32x4 xv[4];
#define ADDLN_LOAD(ROW) do { const size_t ro_ = (size_t)(ROW) * DM + 8 * lane; \
        _Pragma("unroll") for (int j = 0; j < 2; ++j) fw[j] = *(const u32x4*)(F + ro_ + 512 * j); \
        if (IN_SPLIT) { const unsigned char* lo_ = (const unsigned char*)(S + (size_t)(ROW) * DM) + 8 * lane; \
            _Pragma("unroll") for (int j = 0; j < 2; ++j) { hw[j] = *(const u32x4*)(XB + ro_ + 512 * j); lw[j] = *(const u32x2*)(lo_ + 512 * j); } } \
        else { _Pragma("unroll") for (int j = 0; j < 2; ++j) { xv[2 * j] = *(const f32x4*)(base + ro_ + 512 * j); xv[2 * j + 1] = *(const f32x4*)(base + ro_ + 512 * j + 4); } } } while (0)
    if (gw < nrows) ADDLN_LOAD(gw);
    for (int row = gw; row < nrows; row += ngw) {
        const size_t ro = (size_t)row * DM + 8 * lane;
        unsigned char* lo = (unsigned char*)(S + (size_t)row * DM) + 8 * lane;
        f32x4 v[4]; float s = 0.f, q = 0.f;
#pragma unroll
        for (int j = 0; j < 2; ++j)
#pragma unroll
            for (int h = 0; h < 2; ++h) {
                const int c = 2 * j + h;
                if (IN_SPLIT) { const unsigned h0 = hw[j][2 * h], h1 = hw[j][2 * h + 1], l4 = lw[j][h];
                    v[c][0] = bflo(h0) + fp8lo(l4, 0) * (1.0f / 512.0f); v[c][1] = bfhi(h0) + fp8lo(l4, 1) * (1.0f / 512.0f);
                    v[c][2] = bflo(h1) + fp8lo(l4, 2) * (1.0f / 512.0f); v[c][3] = bfhi(h1) + fp8lo(l4, 3) * (1.0f / 512.0f); }
                else v[c] = xv[c];
                const unsigned f0 = fw[j][2 * h], f1 = fw[j][2 * h + 1];
                const f32x4 f = {bflo(f0), bfhi(f0), bflo(f1), bfhi(f1)};
                v[c] = v[c] * ALPHA + f;
                s += (v[c][0] + v[c][1]) + (v[c][2] + v[c][3]);
                q += (v[c][0] * v[c][0] + v[c][1] * v[c][1]) + (v[c][2] * v[c][2] + v[c][3] * v[c][3]);
            }
        const int nrow = row + ngw;
        if (nrow < nrows) ADDLN_LOAD(nrow);
        wave_sum2(s, q, lane);
        const float mean = s * (1.0f / DM);
        const float rstd = 1.0f / sqrtf(fmaxf(q * (1.0f / DM) - mean * mean, 0.f) + LN_EPS);
#pragma unroll
        for (int j = 0; j < 2; ++j) {
            const f32x4 y0 = (v[2 * j] - mean) * rstd * gb[2 * j] + bb[2 * j], y1 = (v[2 * j + 1] - mean) * rstd * gb[2 * j + 1] + bb[2 * j + 1];
            if (OUT_SPLIT) {
                u32x4 w; w.x = pk2(y0[0], y0[1]); w.y = pk2(y0[2], y0[3]); w.z = pk2(y1[0], y1[1]); w.w = pk2(y1[2], y1[3]);
                int l0 = 0, l1 = 0;
                l0 = __builtin_amdgcn_cvt_pk_fp8_f32((y0[0] - bflo(w.x)) * 512.0f, (y0[1] - bfhi(w.x)) * 512.0f, l0, false);
                l0 = __builtin_amdgcn_cvt_pk_fp8_f32((y0[2] - bflo(w.y)) * 512.0f, (y0[3] - bfhi(w.y)) * 512.0f, l0, true);
                l1 = __builtin_amdgcn_cvt_pk_fp8_f32((y1[0] - bflo(w.z)) * 512.0f, (y1[1] - bfhi(w.z)) * 512.0f, l1, false);
                l1 = __builtin_amdgcn_cvt_pk_fp8_f32((y1[2] - bflo(w.w)) * 512.0f, (y1[3] - bfhi(w.w)) * 512.0f, l1, true);
                u32x2 l; l.x = (unsigned)l0; l.y = (unsigned)l1;
                *(u32x4*)(XB + ro + 512 * j) = w; *(u32x2*)(lo + 512 * j) = l;
            } else { *(f32x4*)(S + ro + 512 * j) = y0; *(f32x4*)(S + ro + 512 * j + 4) = y1; }
        }
    }
#undef ADDLN_LOAD
}
__device__ __forceinline__ void fixup_phase(bf16* H, const float* GS, const float* US, const float* cw, const float* cb, int nstrips, int gtid, int nthr) {
    const int total = nstrips * 2 * (DFF / 4);
    for (int idx = gtid; idx < total; idx += nthr) {
        const int cq = idx % (DFF / 4), rest = idx / (DFF / 4), lr = rest & 1, strip = rest >> 1, col = 4 * cq;
        const bool first = ((strip & 31) == 0);
        const f32x4 z = {0.f, 0.f, 0.f, 0.f};
        const f32x4 pm2 = first ? z : *(const f32x4*)(GS + (size_t)((strip - 1) * 4 + 0) * DFF + col);
        const f32x4 pm1 = first ? z : *(const f32x4*)(GS + (size_t)((strip - 1) * 4 + 1) * DFF + col);
        const f32x4 c0 = *(const f32x4*)(GS + (size_t)(strip * 4 + 2) * DFF + col), c1 = *(const f32x4*)(GS + (size_t)(strip * 4 + 3) * DFF + col);
        const f32x4 up = *(const f32x4*)(US + (size_t)(strip * 2 + lr) * DFF + col);
        const f32x4 w0 = *(const f32x4*)(cw + col), w1 = *(const f32x4*)(cw + DFF + col), w2 = *(const f32x4*)(cw + 2 * DFF + col), b4 = *(const f32x4*)(cb + col);
        const f32x4 ga = lr ? pm1 : pm2, gb = lr ? c0 : pm1, gc = lr ? c1 : c0;
        const f32x4 cv = b4 + w0 * ga + w1 * gb + w2 * gc;
        f32x4 hv;
#pragma unroll
        for (int j = 0; j < 4; ++j) hv[j] = gelu_tanh(cv[j]) * up[j];
        u32x2 w; w.x = pk2(hv[0], hv[1]); w.y = pk2(hv[2], hv[3]);
        *(u32x2*)(H + (size_t)(strip * 64 + lr) * DFF + col) = w;
    }
}
__device__ __forceinline__ void attn_block(f32x16& o0, f32x16& o1, float& mrun, float& lrun, const bf16x8 (&bq)[4], const bf16x8 (&kf)[4], const bf16x8 (&vf)[2][2], int kb, int qpos, int hl, int lane) {
    f32x16 s;
#pragma unroll
    for (int i = 0; i < 16; ++i) s[i] = 0.f;
#pragma unroll
    for (int k = 0; k < 4; ++k) s = __builtin_amdgcn_mfma_f32_32x32x16_bf16(kf[k], bq[k], s, 0, 0, 0);
    float mloc = -1e30f;
#pragma unroll
    for (int i = 0; i < 16; ++i) {
        const int kpos = kb + 16 * (i >> 3) + 8 * hl + (i & 7);
        const bool ok = (kpos <= qpos) && (kpos + 128 >= qpos);
        s[i] = ok ? s[i] : -1e30f; mloc = fmaxf(mloc, s[i]);
    }
    mloc = fmaxf(mloc, shfl_xor_l(mloc, 32, lane));
    const float mnew = fmaxf(mrun, mloc), al = __builtin_amdgcn_exp2f(mrun - mnew);
    float ps = 0.f;
#pragma unroll
    for (int i = 0; i < 16; ++i) { s[i] = __builtin_amdgcn_exp2f(s[i] - mnew); ps += s[i]; }
    lrun = lrun * al + ps; mrun = mnew;
#pragma unroll
    for (int i = 0; i < 16; ++i) { o0[i] *= al; o1[i] *= al; }
    u32x4 p0, p1;
    p0.x = pk2(s[0], s[1]); p0.y = pk2(s[2], s[3]); p0.z = pk2(s[4], s[5]); p0.w = pk2(s[6], s[7]);
    p1.x = pk2(s[8], s[9]); p1.y = pk2(s[10], s[11]); p1.z = pk2(s[12], s[13]); p1.w = pk2(s[14], s[15]);
    const bf16x8 pb0 = __builtin_bit_cast(bf16x8, p0), pb1 = __builtin_bit_cast(bf16x8, p1);
    o0 = __builtin_amdgcn_mfma_f32_32x32x16_bf16(vf[0][0], pb0, o0, 0, 0, 0);
    o0 = __builtin_amdgcn_mfma_f32_32x32x16_bf16(vf[0][1], pb1, o0, 0, 0, 0);
    o1 = __builtin_amdgcn_mfma_f32_32x32x16_bf16(vf[1][0], pb0, o1, 0, 0, 0);
    o1 = __builtin_amdgcn_mfma_f32_32x32x16_bf16(vf[1][1], pb1, o1, 0, 0, 0);
}
__device__ __forceinline__ void attn_store(bf16* orow, float* lsep, f32x16& o0, f32x16& o1, float mrun, float lrun, int hl, int lane, bool dry) {
    lrun += shfl_xor_l(lrun, 32, lane);
    const float inv = 1.0f / lrun;
#pragma unroll
    for (int dt = 0; dt < 2; ++dt) {
        const f32x16& o = dt ? o1 : o0;
        u32x2 w[4];
#pragma unroll
        for (int a = 0; a < 4; ++a) { w[a].x = pk2(o[4 * a] * inv, o[4 * a + 1] * inv); w[a].y = pk2(o[4 * a + 2] * inv, o[4 * a + 3] * inv); }
#pragma unroll
        for (int pr = 0; pr < 2; ++pr) {
            const u32x2 snd = hl ? w[2 * pr] : w[2 * pr + 1], own = hl ? w[2 * pr + 1] : w[2 * pr];
            u32x2 rcv;
            rcv.x = (unsigned)__builtin_amdgcn_ds_bpermute((lane ^ 32) << 2, (int)snd.x); rcv.y = (unsigned)__builtin_amdgcn_ds_bpermute((lane ^ 32) << 2, (int)snd.y);
            u32x4 c; if (hl) { c.x = rcv.x; c.y = rcv.y; c.z = own.x; c.w = own.y; } else { c.x = own.x; c.y = own.y; c.z = rcv.x; c.w = rcv.y; }
            if (!dry) *(u32x4*)(orow + 32 * dt + 8 * (2 * pr + hl)) = c;
        }
    }
    if (hl == 0 && !dry) *lsep = mrun + __builtin_amdgcn_logf(lrun);
}
__device__ __forceinline__ void attn_phase(bf16* Qb, const bf16* Kb, const bf16* Vt, float* LSE, int gw, int ngw, int lane, bool dry) {
    const int n = lane & 31, hl = lane >> 5;
    const int kperm = (n & ~12) | ((n & 4) << 1) | ((n & 8) >> 1);
    for (int u = gw; u < 3 * 8192; u += ngw) {
        const int g = u >> 13, v = u & 8191, dsh = 2 * g, L = 2048 >> dsh, ncl = 5 - dsh;
        const int rest = v >> ncl, r = rest & ((1 << dsh) - 1), bh = rest >> dsh;
        const int qc = ((v & ((1 << ncl) - 1)) + (rest >> (11 - ncl))) & ((1 << ncl) - 1);
        const size_t hb = (size_t)(g * 256 + bh) * (2048 * 64);
        bf16* qs = Qb + hb + (size_t)(r * L) * 64;
        const bf16* ks = Kb + hb + (size_t)(r * L) * 64;
        const bf16* vs = Vt + hb + (size_t)r * 64 * L;
        const int q0 = qc * 64, qposA = q0 + n, qposB = q0 + 32 + n;
        bf16x8 bqA[4], bqB[4];
#pragma unroll
        for (int k = 0; k < 4; ++k) { bqA[k] = *(const bf16x8*)(qs + (size_t)qposA * 64 + k * 16 + hl * 8); bqB[k] = *(const bf16x8*)(qs + (size_t)qposB * 64 + k * 16 + hl * 8); }
        f32x16 oA0, oA1, oB0, oB1;
#pragma unroll
        for (int i = 0; i < 16; ++i) { oA0[i] = 0.f; oA1[i] = 0.f; oB0[i] = 0.f; oB1[i] = 0.f; }
        float mA = -1e30f, lA = 0.f, mB = -1e30f, lB = 0.f;
        int kb0 = q0 - 128; if (kb0 < 0) kb0 = 0;
        const int kbl = q0 + 32;
        bf16x8 kf[4], vf[2][2], kfn[4], vfn[2][2];
#pragma unroll
        for (int k = 0; k < 4; ++k) kf[k] = *(const bf16x8*)(ks + (size_t)(kb0 + kperm) * 64 + k * 16 + hl * 8);
#pragma unroll
        for (int dt = 0; dt < 2; ++dt)
#pragma unroll
            for (int c = 0; c < 2; ++c) vf[dt][c] = *(const bf16x8*)(vs + (size_t)(32 * dt + n) * L + kb0 + 16 * c + 8 * hl);
        for (int kb = kb0; kb <= kbl; kb += 32) {
            asm volatile("" :: "v"(kf[0]), "v"(kf[1]), "v"(kf[2]), "v"(kf[3]), "v"(vf[0][0]), "v"(vf[0][1]), "v"(vf[1][0]), "v"(vf[1][1]));
            const int kn = (kb + 32 <= kbl) ? kb + 32 : kb;
#pragma unroll
            for (int k = 0; k < 4; ++k) kfn[k] = *(const bf16x8*)(ks + (size_t)(kn + kperm) * 64 + k * 16 + hl * 8);
#pragma unroll
            for (int dt = 0; dt < 2; ++dt)
#pragma unroll
                for (int c = 0; c < 2; ++c) vfn[dt][c] = *(const bf16x8*)(vs + (size_t)(32 * dt + n) * L + kn + 16 * c + 8 * hl);
            if (kb <= q0) attn_block(oA0, oA1, mA, lA, bqA, kf, vf, kb, qposA, hl, lane);
            if (kb >= q0 - 96) attn_block(oB0, oB1, mB, lB, bqB, kf, vf, kb, qposB, hl, lane);
#pragma unroll
            for (int k = 0; k < 4; ++k) kf[k] = kfn[k];
#pragma unroll
            for (int dt = 0; dt < 2; ++dt)
#pragma unroll
                for (int c = 0; c < 2; ++c) vf[dt][c] = vfn[dt][c];
        }
        float* lp = LSE + (size_t)(g * 256 + bh) * 2048 + r * L;
        attn_store(qs + (size_t)qposA * 64, lp + qposA, oA0, oA1, mA, lA, hl, lane, dry);
        attn_store(qs + (size_t)qposB * 64, lp + qposB, oB0, oB1, mB, lB, hl, lane, dry);
    }
}
__device__ __forceinline__ void combine_phase(const bf16* __restrict__ Ob, const float* __restrict__ LSE, bf16* __restrict__ ATT, int gtid, int nthr) {
    constexpr int NI = 4;
    for (int idx0 = gtid; idx0 < MH * 128; idx0 += NI * nthr) {
        float l[NI][3]; u32x4 ov[NI][3];
#pragma unroll
        for (int k = 0; k < NI; ++k) {
            const int idx = idx0 + k * nthr;
            const int oct = idx & 7, h = (idx >> 3) & 15, tl = idx >> 7, b = (tl >> 11) & 15, t = tl & 2047;
#pragma unroll
            for (int g = 0; g < 3; ++g) {
                const int dsh = 2 * g, pos = ((t & ((1 << dsh) - 1)) << (11 - dsh)) + (t >> dsh);
                const size_t ro = (size_t)((g * 16 + b) * 16 + h) * 2048 + pos;
                l[k][g] = LSE[ro]; ov[k][g] = *(const u32x4*)(Ob + ro * 64 + oct * 8);
            }
        }
#pragma unroll
        for (int k = 0; k < NI; ++k) {
            const int idx = idx0 + k * nthr;
            if (idx >= MH * 128) break;
            const int oct = idx & 7, h = (idx >> 3) & 15, tl = idx >> 7;
            const float mx = fmaxf(l[k][0], fmaxf(l[k][1], l[k][2]));
            float w[3];
#pragma unroll
            for (int g = 0; g < 3; ++g) w[g] = __builtin_amdgcn_exp2f(l[k][g] - mx);
            const float inv = 1.0f / (w[0] + w[1] + w[2]);
            u32x4 o;
#pragma unroll
            for (int e = 0; e < 4; ++e) {
                float lo = 0.f, hi = 0.f;
#pragma unroll
                for (int g = 0; g < 3; ++g) { lo += w[g] * bflo(ov[k][g][e]); hi += w[g] * bfhi(ov[k][g][e]); }
                o[e] = pk2(lo * inv, hi * inv);
            }
            *(u32x4*)(ATT + (size_t)tl * DM + h * 64 + oct * 8) = o;
        }
    }
}

#define XB_TMO      128
#define XB_XCNT(j)  (256  + 64 * (j))
#define XB_XSUB(j)  (1280 + 64 * (j))
#define XB_XGEN(j)  (2304 + 64 * (j))
#define XB_TOP      3328
#define XB_TOPGEN   3392
#define XCD_BAR_WORDS 3456
#define XB_SPIN_CAP (1u << 22)
__device__ __forceinline__ unsigned xb_ld(unsigned* p)              { return __hip_atomic_load(p, __ATOMIC_RELAXED, __HIP_MEMORY_SCOPE_AGENT); }
__device__ __forceinline__ unsigned xb_add(unsigned* p, unsigned v) { return __hip_atomic_fetch_add(p, v, __ATOMIC_RELAXED, __HIP_MEMORY_SCOPE_AGENT); }
__device__ __forceinline__ unsigned xb_xcc_id() { return (unsigned)__builtin_amdgcn_s_getreg((3 << 11) | 20) & 0xFu; }
#define XB_SPIN(cond, bar) do { unsigned _sp = 0; while (cond) { __builtin_amdgcn_s_sleep(1); \
    if ((++_sp & 255u) == 0u) { if (xb_ld(&(bar)[XB_TMO])) break; if (_sp > XB_SPIN_CAP) { atomicAdd(&(bar)[XB_TMO], 1u); break; } } } } while (0)
__device__ __forceinline__ void xcd_barrier_complete(unsigned* bar, unsigned x, unsigned& nloc, unsigned& nx) {
    const unsigned G = gridDim.x * gridDim.y * gridDim.z;
    unsigned sum, cnt, mine, sp = 0u;
    for (;;) {
        sum = 0u; cnt = 0u; mine = 0u;
#pragma unroll
        for (unsigned j = 0; j < 16; ++j) { const unsigned c = xb_ld(&bar[XB_XCNT(j)]); sum += c; cnt += (c > 0u) ? 1u : 0u; mine = (j == x) ? c : mine; }
        if (sum == G) break;
        __builtin_amdgcn_s_sleep(1);
        if ((++sp & 255u) == 0u) { if (xb_ld(&bar[XB_TMO])) break; if (sp > XB_SPIN_CAP) { atomicAdd(&bar[XB_TMO], 1u); break; } }
    }
    nloc = mine > 0u ? mine : 1u; nx = cnt > 0u ? cnt : 1u;
}
__device__ __forceinline__ void xcd_barrier(unsigned* bar, unsigned x, volatile LAS unsigned* st, int tid) {
    asm volatile("s_waitcnt vmcnt(0)" ::: "memory");
    __syncthreads();
    if (tid == 0) {
        __builtin_amdgcn_s_waitcnt(0);
        unsigned nloc = st[0], nx = st[1];
        if (nloc == 0u) { xcd_barrier_complete(bar, x, nloc, nx); st[0] = nloc; st[1] = nx; }
        const unsigned old = xb_add(&bar[XB_XSUB(x)], 1u);
        const unsigned gen = old / nloc;
        if (old + 1u == (gen + 1u) * nloc) {
            __builtin_amdgcn_fence(__ATOMIC_RELEASE, "agent");
            asm volatile("s_waitcnt vmcnt(0)" ::: "memory");
            const unsigned og = xb_add(&bar[XB_TOP], 1u);
            const unsigned tg = og / nx;
            if (og + 1u == (tg + 1u) * nx) xb_add(&bar[XB_TOPGEN], 1u);
            else XB_SPIN(xb_ld(&bar[XB_TOPGEN]) == tg, bar);
            __builtin_amdgcn_fence(__ATOMIC_ACQUIRE, "agent");
            xb_add(&bar[XB_XGEN(x)], 1u);
            asm volatile("s_waitcnt vmcnt(0)" ::: "memory");
        } else {
            XB_SPIN(xb_ld(&bar[XB_XGEN(x)]) == gen, bar);
            __builtin_amdgcn_fence(__ATOMIC_ACQUIRE, "agent");
            asm volatile("s_waitcnt vmcnt(0)" ::: "memory");
        }
    }
    __syncthreads();
}

__device__ __forceinline__ int get_lane() { int l; asm volatile("v_mbcnt_lo_u32_b32 %0, -1, 0\n\tv_mbcnt_hi_u32_b32 %0, -1, %0" : "=&v"(l)); return l; }
enum Kind { K_PREP = 0, K_POOL, K_POOLGEMM, K_LN1, K_GU, K_FIXUP, K_DOWN, K_LN2, K_KV, K_QPROJ, K_ATTN, K_COMBINE, K_OPROJ };
constexpr int NPH = 1 + 14 + 2 * 19;
__global__ void __launch_bounds__(NTHREADS, 2) yoco_fwd(Params p_unused) {
    extern __shared__ __attribute__((aligned(16))) unsigned char lds_raw[];
    LAS unsigned char* lds = (LAS unsigned char*)lds_raw;
    cg::grid_group grid = cg::this_grid();
    typedef const Params __attribute__((address_space(4))) CParams;
    CParams* pp0 = (CParams*)__builtin_amdgcn_kernarg_segment_ptr();
    const int wave0 = __builtin_amdgcn_readfirstlane((int)threadIdx.x >> 6);
    volatile LAS unsigned* bst = (volatile LAS unsigned*)(lds + 131072);
    if (threadIdx.x < 4) bst[threadIdx.x] = 0u;
    __syncthreads();
    unsigned* bar = (unsigned*)(pp0->ws + WS_BAR);
    const unsigned xcc = xb_xcc_id();
    if (threadIdx.x == 0) (void)xb_add(&bar[XB_XCNT(xcc)], 1u);
    grid.sync();
    const int hi = pp0->ph_hi < NPH ? pp0->ph_hi : NPH;
    for (int ph = pp0->ph_lo; ph < hi; ++ph) {
        CParams* pq = pp0; asm volatile("" : "+s"(pq));
        CParams& p = *pq;
        int wave = wave0, bx = blockIdx.x, G = gridDim.x;
        asm volatile("" : "+s"(wave)); asm volatile("" : "+s"(bx)); asm volatile("" : "+s"(G));
        const int gw = bx * NWAVES + wave, ngw = G * NWAVES, nthr = G * NTHREADS;
#define LT const int lane = get_lane(), tid = wave * 64 + lane, gtid = bx * NTHREADS + tid; (void)lane; (void)tid; (void)gtid;
        int kind, layer = 0, half = 0; bool full = true;
        if (ph == 0) kind = K_PREP;
        else if (ph < 15) { layer = (ph - 1) / 7; kind = K_POOL + (ph - 1) % 7; }
        else {
            const int q = ph - 15, r = q % 19; half = q / 19; full = false;
            if (r == 0) kind = K_KV;
            else { const int k = (r - 1) % 9; layer = 2 + (r - 1) / 9; kind = k == 0 ? K_QPROJ : k == 1 ? K_ATTN : k == 2 ? K_COMBINE : k == 3 ? K_OPROJ : k == 4 ? K_LN1 : k == 5 ? K_GU : k == 6 ? K_FIXUP : k == 7 ? K_DOWN : K_LN2; }
        }
        unsigned char* ws = p.ws;
        const int nrows = full ? MTOK : MH; const size_t roff = full ? 0 : (size_t)half * MH;
        float* Sh = p.out + roff * DM; bf16* XBh = (bf16*)(ws + WS_XB) + roff * DM;
        bf16* HB = (bf16*)(ws + WS_H);
        switch (kind) {
        case K_PREP: { LT prep_phase(p, lds, gw, ngw, lane, wave); } break;
        case K_POOL: { LT pool_phase(layer == 0 ? p.x : p.out, HB, gtid, nthr); } break;
        case K_POOLGEMM: { LT
            pg8::Gemm g{HB, (const bf16*)(ws + WS_WPOOL) + (size_t)layer * 4 * 65536, MTOK * 4, 1024, 256};
            PoolOrder O{G, bx, MTOK / 256}; EpiF E{(bf16*)(ws + WS_FA), p.pool_scale + layer * DM, true};
            pg8::gemm_phase<EpiF, PoolOrder, true, true>(lds, g, O, E, tid);
        } break;
        case K_LN1: { LT
            if (full) addln_phase<false, true>(layer == 0 ? p.x : p.out, Sh, (const bf16*)(ws + WS_FA), XBh, p.ln1_g + layer * DM, p.ln1_b + layer * DM, nrows, gw, ngw, lane);
            else addln_phase<true, true>(Sh, Sh, (const bf16*)(ws + WS_H), XBh, p.ln1_g + layer * DM, p.ln1_b + layer * DM, nrows, gw, ngw, lane);
        } break;
        case K_LN2: { LT
            const bf16* Fp = full ? (const bf16*)(ws + WS_FA) : (const bf16*)(ws + WS_ATT);
            if (layer == 0 || layer == 3) addln_phase<true, false>(Sh, Sh, Fp, XBh, p.ln2_g + layer * DM, p.ln2_b + layer * DM, nrows, gw, ngw, lane);
            else addln_phase<true, true>(Sh, Sh, Fp, XBh, p.ln2_g + layer * DM, p.ln2_b + layer * DM, nrows, gw, ngw, lane);
        } break;
        case K_GU: { LT
            pg8::Gemm g{XBh, (const bf16*)(ws + WS_WGU) + (size_t)layer * 2 * DFF * DM, nrows, 2 * DFF, DM};
            pg8::StaticOrder O; O.init(nrows, 2 * DFF, G, bx);
            EpiGU E{HB, (float*)(ws + WS_GS), (float*)(ws + WS_US), p.conv_w + (size_t)layer * 3 * DFF, p.conv_b + (size_t)layer * DFF};
            pg8::gemm_phase<EpiGU, pg8::StaticOrder, true, true>(lds, g, O, E, tid);
        } break;
        case K_FIXUP: { LT fixup_phase(HB, (const float*)(ws + WS_GS), (const float*)(ws + WS_US), p.conv_w + (size_t)layer * 3 * DFF, p.conv_b + (size_t)layer * DFF, nrows / 64, gtid, nthr); } break;
        case K_DOWN: case K_OPROJ: { LT
            const bool dn = (kind == K_DOWN);
            pg8::Gemm g{dn ? (const bf16*)HB : (const bf16*)(ws + WS_ATT), dn ? (const bf16*)(ws + WS_WDOWN) + (size_t)layer * DM * DFF : (const bf16*)(ws + WS_WO) + (size_t)(layer - 2) * DM * DM, nrows, DM, dn ? DFF : DM};
            pg8::StaticOrder O; O.init(nrows, DM, G, bx);
            EpiF E{dn ? (full ? (bf16*)(ws + WS_FA) : (bf16*)(ws + WS_ATT)) : HB, nullptr, false};
            pg8::gemm_phase<EpiF, pg8::StaticOrder, true, true>(lds, g, O, E, tid);
        } break;
        case K_KV: case K_QPROJ: { LT
            const bool isq = (kind == K_QPROJ);
            const float* cosT = (const float*)(ws + WS_ROPE);
            pg8::Gemm g{XBh, isq ? (const bf16*)(ws + WS_WQ) + (size_t)(layer - 2) * QD * DM : (const bf16*)(ws + WS_WK), MH, QD, DM};
            pg8::StaticOrder O; O.init(MH, QD, G, bx); EpiRope E{isq ? HB : (bf16*)(ws + WS_K), cosT, cosT + SEQ * 32, isq ? QSCALE : 1.0f};
            pg8::gemm_phase<EpiRope, pg8::StaticOrder, true, true>(lds, g, O, E, tid);
            if (!isq) {
                bf16* VB = (bf16*)(ws + WS_V);
                pg8::StaticOrder OV; OV.init(DM, MH, G, bx);
                { pg8::Gemm gv{(const bf16*)(ws + WS_WV), XBh, DM, MH, DM}; EpiVt<0> EV{VB}; pg8::gemm_phase<EpiVt<0>, pg8::StaticOrder, true, true>(lds, gv, OV, EV, tid); }
                { pg8::Gemm gv{(const bf16*)(ws + WS_WV) + (size_t)DM * DM, XBh, DM, MH, DM}; EpiVt<1> EV{VB}; pg8::gemm_phase<EpiVt<1>, pg8::StaticOrder, true, true>(lds, gv, OV, EV, tid); }
                { pg8::Gemm gv{(const bf16*)(ws + WS_WV) + (size_t)2 * DM * DM, XBh, DM, MH, DM}; EpiVt<2> EV{VB}; pg8::gemm_phase<EpiVt<2>, pg8::StaticOrder, true, true>(lds, gv, OV, EV, tid); }
            }
        } break;
        case K_ATTN: { LT
            const int vb = ((G & 7) == 0) ? (bx & 7) * (G >> 3) + (bx >> 3) : bx;
            attn_phase(HB, (const bf16*)(ws + WS_K), (const bf16*)(ws + WS_V), (float*)(ws + WS_LSE), vb * NWAVES + wave, ngw, lane, false); } break;
        case K_COMBINE: { LT combine_phase(HB, (const float*)(ws + WS_LSE), (bf16*)(ws + WS_ATT), gtid, nthr); } break;
        default: break;
        }
        const bool nosync = (kind == K_PREP || kind == K_KV);
        if (ph + 1 < hi && !nosync) xcd_barrier(bar, xcc, bst, wave * 64 + get_lane());
#undef LT
    }
}

extern "C" void kernel_launch(void* const* d_in, const int* in_sizes, int n_in, void* d_out, int out_size, void* d_ws, size_t ws_size, hipStream_t stream) {
    static int grid = 0;
    if (grid == 0) {
        if (n_in != 15 || out_size != MTOK * DM || ws_size < WS_END) { fprintf(stderr, "kernel_launch: unexpected shapes (n_in %d, out %d, ws %zu)\n", n_in, out_size, ws_size); grid = -1; return; }
        int dev = 0, cus = 0, per_cu = 0;
        hipGetDevice(&dev);
        hipDeviceGetAttribute(&cus, hipDeviceAttributeMultiprocessorCount, dev);
        if (hipFuncSetAttribute((const void*)yoco_fwd, hipFuncAttributeMaxDynamicSharedMemorySize, LDS_BYTES) != hipSuccess) { fprintf(stderr, "kernel_launch: hipFuncSetAttribute failed\n"); grid = -1; return; }
        hipOccupancyMaxActiveBlocksPerMultiprocessor(&per_cu, (const void*)yoco_fwd, NTHREADS, LDS_BYTES);
        (void)hipGetLastError();
        if (per_cu < 1) fprintf(stderr, "kernel_launch: occupancy query reports %d blocks per CU\n", per_cu);
        grid = cus > 0 ? cus : 256;
    }
    if (grid < 0) return;
    Params p{};
    p.x = (const float*)d_in[0]; p.pool_w = (const float*)d_in[1]; p.pool_scale = (const float*)d_in[2]; p.w_q = (const float*)d_in[3]; p.w_kv = (const float*)d_in[4];
    p.w_o = (const float*)d_in[5]; p.w_gate = (const float*)d_in[6]; p.w_up = (const float*)d_in[7]; p.conv_w = (const float*)d_in[8]; p.conv_b = (const float*)d_in[9];
    p.w_down = (const float*)d_in[10]; p.ln1_g = (const float*)d_in[11]; p.ln1_b = (const float*)d_in[12]; p.ln2_g = (const float*)d_in[13]; p.ln2_b = (const float*)d_in[14];
    p.out = (float*)d_out; p.ws = (unsigned char*)d_ws;
    for (int i = 0; i < 32; ++i) p.inv_freq[i] = pow(10000.0, -(double)(2 * i) / 64.0);
    p.ph_lo = 0; p.ph_hi = 1000;
    if (hipMemsetAsync((unsigned char*)d_ws + WS_BAR, 0, XCD_BAR_WORDS * 4, stream) != hipSuccess) { fprintf(stderr, "kernel_launch: memset of the barrier words failed\n"); return; }
    void* args[] = {&p};
    hipError_t e = hipLaunchCooperativeKernel((const void*)yoco_fwd, dim3(grid), dim3(NTHREADS), args, LDS_BYTES, stream);
    if (e != hipSuccess) fprintf(stderr, "kernel_launch: cooperative launch failed: %s (grid %d)\n", hipGetErrorString(e), grid);
}
```

```cpp
#include <hip/hip_runtime.h>
#include <hip/hip_cooperative_groups.h>
#include <cstdio>
#include <cstdint>
#include <cmath>
namespace cg = cooperative_groups;
namespace pg8 {
#define PG8_LAS __attribute__((address_space(3)))
typedef unsigned short bf16_t;
typedef short bf16x8 __attribute__((ext_vector_type(8)));
typedef float f32x4 __attribute__((ext_vector_type(4)));
typedef unsigned u32x4 __attribute__((ext_vector_type(4)));
constexpr int BM = 256, BK = 64, HALF = 128, HTB = HALF * BK * 2  , STAGE_BYTES = 8 * HTB, NXCD = 8, WGM = 8;

__host__ __device__ __forceinline__ int lds_byte(int r, int c) { const int st = (r >> 4) * 2 + (c >> 5), rr = r & 15, cc = c & 31, ob = rr * 64 + cc * 2; return st * 1024 + (ob ^ (((ob >> 9) & 1) << 5)); }
__host__ __device__ __forceinline__ void stage_rc(int b, int& R, int& C) { const int st = b / 1024, sb = b % 1024, swz = sb ^ (((sb >> 9) & 1) << 5); R = (st >> 1) * 16 + swz / 64; C = (st & 1) * 32 + (swz % 64) / 2; }
__host__ __device__ __forceinline__ int perm32(int rho) { const int n = rho >> 4, i = rho & 15; return 8 * (i >> 2) + 4 * n + (i & 3); }

struct Unit { int pm, pn; };
struct Gemm { const bf16_t* A; const bf16_t* Bt; int M, N, K; };

struct StaticOrder {
    int nM, nN, nwg, G, c;
    __host__ __device__ void init(int M, int N, int G_, int c_) { nM = M / BM; nN = N / BM; nwg = nM * nN; G = G_; c = c_; }
    __host__ __device__ bool next(int i, Unit& u) const {
        const long L = (long)i * G + c; if (L >= nwg) return false;
        int wgid = (int)L; { const int q = nwg / NXCD, r = nwg % NXCD, xcd = wgid % NXCD, off = wgid / NXCD; wgid = (xcd < r ? xcd * (q + 1) : r * (q + 1) + (xcd - r) * q) + off; }
        const int nig = WGM * nN, gid = wgid / nig, fm = gid * WGM, gsz = (nM - fm) < WGM ? (nM - fm) : WGM;
        u.pm = fm + ((wgid % nig) % gsz); u.pn = (wgid % nig) / gsz; return true;
    }
    __device__ __forceinline__ void a_ready(const Unit&) const {}
    __device__ __forceinline__ void done(const Unit&) const {}
};

__device__ __forceinline__ unsigned cvt_pk_bf16(float lo, float hi) { unsigned r; asm volatile("v_cvt_pk_bf16_f32 %0, %1, %2" : "=v"(r) : "v"(lo), "v"(hi)); return r; }
template <class Epi, class Sched, bool ALIGN_EPI = false, bool SP2 = false>
__device__ __forceinline__ void gemm_phase(PG8_LAS unsigned char* lds, const Gemm g, const Sched& S, const Epi& E, int tid_in) {
    int tid_ = tid_in; asm volatile("" : "+v"(tid_)); const int tid = tid_, wid = __builtin_amdgcn_readfirstlane(tid >> 6), lane = tid & 63, wr = wid >> 2, wc = wid & 3, fr = lane & 15, fq = lane >> 4;
    const int K = g.K, nt = K / BK;
    unsigned voffA[2], voffB[2];
#pragma unroll
    for (int i = 0; i < 2; ++i) { int R, C; stage_rc(tid * 16 + i * 8192, R, C); const int Rb = Epi::bmap(Epi::PERM ? ((R & ~31) + perm32(R & 31)) : R);
        voffA[i] = (unsigned)(Epi::amap(R) * K + C) * 2u; voffB[i] = (unsigned)(Rb * K + C) * 2u; }
    const size_t kstep = (size_t)(BK * 2);
    const size_t hstep = (size_t)HALF * K * 2;
    const size_t tstep = 2 * hstep;
    const unsigned ldsw = (unsigned)wid * 1024u;
    const int aoff = lds_byte(wr * 64 + fr, fq * 8), boff = lds_byte(wc * 32 + fr, fq * 8);
#define PG8_SA(b, h) (((b) * 2 + (h)) * HTB)
#define PG8_SB(b, h) ((4 + (b) * 2 + (h)) * HTB)
#define PG8_STAGE(bufoff, gbase, voff) do { _Pragma("unroll") for (int _i = 0; _i < 2; ++_i) \
        __builtin_amdgcn_global_load_lds((const unsigned*)((const char*)(gbase) + (voff)[_i]), (PG8_LAS unsigned*)(lds + (bufoff) + ldsw + _i * 8192), 16, 0, 0); } while (0)
#define PG8_LDA(dst, b, h) do { _Pragma("unroll") for (int m = 0; m < 4; ++m) _Pragma("unroll") for (int k = 0; k < 2; ++k) dst[m][k] = *(const PG8_LAS bf16x8*)(lds + PG8_SA(b, h) + aoff + m * 2048 + k * 1024); } while (0)
#define PG8_LDB(dst, b, h) do { _Pragma("unroll") for (int n = 0; n < 2; ++n) _Pragma("unroll") for (int k = 0; k < 2; ++k) dst[n][k] = *(const PG8_LAS bf16x8*)(lds + PG8_SB(b, h) + boff + n * 2048 + k * 1024); } while (0)
#define PG8_MMA(ai, bj, At, Bt) do { __builtin_amdgcn_s_setprio(1); _Pragma("unroll") for (int m = 0; m < 4; ++m) _Pragma("unroll") for (int n = 0; n < 2; ++n) _Pragma("unroll") for (int k = 0; k < 2; ++k) \
        acc[ai][bj][m][n] = __builtin_amdgcn_mfma_f32_16x16x32_bf16(Bt[n][k], At[m][k], acc[ai][bj][m][n], 0, 0, 0); __builtin_amdgcn_s_setprio(0); } while (0)
#define PG8_WAIT_V(n) asm volatile("s_waitcnt vmcnt(" #n ")" ::: "memory")
#define PG8_WAIT_L(n) asm volatile("s_waitcnt lgkmcnt(" #n ")" ::: "memory")
#define PG8_BAR __builtin_amdgcn_s_barrier()
#define PG8_SCHED __builtin_amdgcn_sched_barrier(0)
    Unit cur, nxt; int ui = 0;
    if (!S.next(0, cur)) return;
    f32x4 acc[2][2][4][2];
#pragma unroll
    for (int a = 0; a < 2; ++a)
#pragma unroll
        for (int b = 0; b < 2; ++b)
#pragma unroll
            for (int m = 0; m < 4; ++m)
#pragma unroll
                for (int n = 0; n < 2; ++n) acc[a][b][m][n] = (f32x4){0.f, 0.f, 0.f, 0.f};
    bf16x8 At[4][2], B0[2][2], B1[2][2];
    const char* cA = (const char*)g.A + (size_t)cur.pm * tstep; const char* cB = (const char*)g.Bt + (size_t)cur.pn * tstep;
    S.a_ready(cur);
    if constexpr (SP2) {
        PG8_STAGE(PG8_SB(0, 0), cB, voffB); PG8_STAGE(PG8_SB(0, 1), cB + hstep, voffB); PG8_STAGE(PG8_SA(0, 0), cA, voffA); PG8_STAGE(PG8_SA(0, 1), cA + hstep, voffA);
        if (wr == 1) PG8_BAR;
        PG8_WAIT_V(2); PG8_BAR;
        PG8_STAGE(PG8_SB(1, 0), cB + kstep, voffB); PG8_STAGE(PG8_SA(1, 0), cA + kstep, voffA); PG8_STAGE(PG8_SB(1, 1), cB + hstep + kstep, voffB);
        PG8_WAIT_V(6); PG8_BAR;
    } else {
        PG8_STAGE(PG8_SB(0, 0), cB, voffB); PG8_STAGE(PG8_SA(0, 0), cA, voffA); PG8_STAGE(PG8_SB(0, 1), cB + hstep, voffB); PG8_STAGE(PG8_SA(0, 1), cA + hstep, voffA);
        if (wr == 1) PG8_BAR;
        PG8_WAIT_V(4); PG8_BAR;
        PG8_STAGE(PG8_SB(1, 0), cB + kstep, voffB); PG8_STAGE(PG8_SA(1, 0), cA + kstep, voffA); PG8_STAGE(PG8_SB(1, 1), cB + hstep + kstep, voffB);
        PG8_WAIT_V(6); PG8_BAR;
    }
    for (;;) {
        const bool has_next = S.next(ui + 1, nxt);
        const char* nA = has_next ? (const char*)g.A + (size_t)nxt.pm * tstep : cA; const char* nB = has_next ? (const char*)g.Bt + (size_t)nxt.pn * tstep : cB;
        for (int t = 0; t < nt; t += 2) {
            const bool last = (t == nt - 2);
            const char* a1 = cA + (size_t)(t + 1) * kstep;
            const char* a2 = last ? nA : cA + (size_t)(t + 2) * kstep; const char* b2 = last ? nB : cB + (size_t)(t + 2) * kstep;
            const char* a3 = a2 + kstep; const char* b3 = b2 + kstep;
            if (last && has_next) S.a_ready(nxt);
            if constexpr (SP2) {
            PG8_LDB(B0, 0, 0); PG8_LDB(B1, 0, 1); PG8_SCHED; PG8_LDA(At, 0, 0); PG8_STAGE(PG8_SA(1, 1), a1 + hstep, voffA);
            PG8_WAIT_V(8); PG8_WAIT_L(0); PG8_BAR; PG8_MMA(0, 0, At, B0); PG8_MMA(0, 1, At, B1); PG8_BAR; PG8_SCHED;
            PG8_LDA(At, 0, 1); PG8_STAGE(PG8_SB(0, 0), b2, voffB); PG8_STAGE(PG8_SB(0, 1), b2 + hstep, voffB); PG8_STAGE(PG8_SA(0, 0), a2, voffA);
            PG8_WAIT_V(8); PG8_WAIT_L(0); PG8_BAR; PG8_MMA(1, 0, At, B0); PG8_MMA(1, 1, At, B1); PG8_BAR; PG8_SCHED;
            PG8_LDB(B0, 1, 0); PG8_LDB(B1, 1, 1); PG8_SCHED; PG8_LDA(At, 1, 0); PG8_STAGE(PG8_SA(0, 1), a2 + hstep, voffA);
            PG8_WAIT_V(8); PG8_WAIT_L(0); PG8_BAR; PG8_MMA(0, 0, At, B0); PG8_MMA(0, 1, At, B1); PG8_BAR; PG8_SCHED;
            PG8_LDA(At, 1, 1); PG8_STAGE(PG8_SB(1, 0), b3, voffB); PG8_STAGE(PG8_SB(1, 1), b3 + hstep, voffB); PG8_STAGE(PG8_SA(1, 0), a3, voffA);
            PG8_WAIT_V(8); PG8_WAIT_L(0); PG8_BAR; PG8_MMA(1, 0, At, B0); PG8_MMA(1, 1, At, B1); PG8_BAR; PG8_SCHED;
            } else {
            PG8_LDB(B0, 0, 0); PG8_SCHED; PG8_LDA(At, 0, 0); PG8_STAGE(PG8_SA(1, 1), a1 + hstep, voffA);
            PG8_WAIT_L(8); PG8_BAR; PG8_WAIT_L(0); PG8_MMA(0, 0, At, B0); PG8_BAR; PG8_SCHED;
            PG8_LDB(B1, 0, 1); PG8_STAGE(PG8_SB(0, 0), b2, voffB);
            PG8_BAR; PG8_WAIT_L(0); PG8_MMA(0, 1, At, B1); PG8_BAR;
            PG8_LDA(At, 0, 1); PG8_STAGE(PG8_SA(0, 0), a2, voffA);
            PG8_BAR; PG8_WAIT_L(0); PG8_MMA(1, 0, At, B0); PG8_BAR; PG8_SCHED;
            PG8_STAGE(PG8_SB(0, 1), b2 + hstep, voffB);
            PG8_WAIT_V(6); PG8_BAR; PG8_MMA(1, 1, At, B1); PG8_BAR;
            PG8_LDB(B0, 1, 0); PG8_SCHED; PG8_LDA(At, 1, 0); PG8_STAGE(PG8_SA(0, 1), a2 + hstep, voffA);
            PG8_WAIT_L(8); PG8_BAR; PG8_WAIT_L(0); PG8_MMA(0, 0, At, B0); PG8_BAR; PG8_SCHED;
            PG8_LDB(B1, 1, 1); PG8_STAGE(PG8_SB(1, 0), b3, voffB);
            PG8_BAR; PG8_WAIT_L(0); PG8_MMA(0, 1, At, B1); PG8_BAR;
            PG8_LDA(At, 1, 1); PG8_STAGE(PG8_SA(1, 0), a3, voffA);
            PG8_BAR; PG8_WAIT_L(0); PG8_MMA(1, 0, At, B0); PG8_BAR; PG8_SCHED;
            PG8_STAGE(PG8_SB(1, 1), b3 + hstep, voffB);
            PG8_WAIT_V(6); PG8_BAR; PG8_MMA(1, 1, At, B1); PG8_BAR;
            }
        }
        if constexpr (ALIGN_EPI) { if (wr == 0) PG8_BAR; }
        if constexpr (!Epi::AFTER_DRAIN) { E(acc, cur, wr, wc, fr, fq); S.done(cur); }
        if (!has_next) break;
#pragma unroll
        for (int a = 0; a < 2; ++a)
#pragma unroll
            for (int b = 0; b < 2; ++b)
#pragma unroll
                for (int m = 0; m < 4; ++m)
#pragma unroll
                    for (int n = 0; n < 2; ++n) acc[a][b][m][n] = (f32x4){0.f, 0.f, 0.f, 0.f};
        cur = nxt; cA = nA; cB = nB; ++ui;
        if constexpr (ALIGN_EPI) { if (wr == 1) PG8_BAR; }
    }
    PG8_WAIT_V(0);
    if constexpr (!ALIGN_EPI) { if (wr == 0) PG8_BAR; }
    PG8_BAR;
    if constexpr (Epi::AFTER_DRAIN) { E.fused(acc, cur, wr, wc, fr, fq, lds, wid, lane); S.done(cur); }
#undef PG8_SA
#undef PG8_SB
#undef PG8_STAGE
#undef PG8_LDA
#undef PG8_LDB
#undef PG8_MMA
#undef PG8_WAIT_V
#undef PG8_WAIT_L
#undef PG8_BAR
#undef PG8_SCHED
}
}

#define LAS __attribute__((address_space(3)))
typedef unsigned short bf16;
typedef float f32x4 __attribute__((ext_vector_type(4)));
typedef float f32x16 __attribute__((ext_vector_type(16)));
typedef short bf16x8 __attribute__((ext_vector_type(8)));
typedef unsigned u32x4 __attribute__((ext_vector_type(4)));
typedef unsigned u32x2 __attribute__((ext_vector_type(2)));
typedef __bf16 bf16x2_t __attribute__((ext_vector_type(2)));
typedef float f32x2_t __attribute__((ext_vector_type(2)));

constexpr int DM = 1024, SEQ = 2048, MTOK = 65536, DFF = 2816, QD = 3072;
constexpr int MH = 32768;
constexpr float ALPHA = 1.6817928305074290f;
constexpr float LN_EPS = 1e-5f;
constexpr float QSCALE = 0.125f * 1.4426950408889634f;
constexpr int NTHREADS = 512, NWAVES = 8;
constexpr int LDS_BYTES = 131072 + 1024;

constexpr size_t MiB = 1u << 20;
constexpr size_t WS_WPOOL = 0;
constexpr size_t WS_WGU = 1 * MiB;
constexpr size_t WS_WDOWN = 45 * MiB;
constexpr size_t WS_WQ = 67 * MiB;
constexpr size_t WS_WK = 79 * MiB;
constexpr size_t WS_WV = 85 * MiB;
constexpr size_t WS_WO = 91 * MiB;
constexpr size_t WS_ROPE = 95 * MiB;
constexpr size_t WS_BAR = 95 * MiB + 768 * 1024;
constexpr size_t WS_XB = 96 * MiB;
constexpr size_t WS_GS = 224 * MiB;
constexpr size_t WS_US = 268 * MiB;
constexpr size_t WS_LSE = 290 * MiB;
constexpr size_t WS_ATT = 296 * MiB;
constexpr size_t WS_H = 360 * MiB;
constexpr size_t WS_K = 552 * MiB;
constexpr size_t WS_V = 744 * MiB;
constexpr size_t WS_FA = 712 * MiB;
constexpr size_t WS_STATS = 936 * MiB;
constexpr size_t WS_END = 937 * MiB;

struct Params {
    const float* x; const float* pool_w; const float* pool_scale; const float* w_q; const float* w_kv; const float* w_o;
    const float* w_gate; const float* w_up; const float* conv_w; const float* conv_b; const float* w_down;
    const float* ln1_g; const float* ln1_b; const float* ln2_g; const float* ln2_b;
    float* out; unsigned char* ws;
    double inv_freq[32];
    int ph_lo, ph_hi;
};

__device__ __forceinline__ unsigned pk2(float lo, float hi) { f32x2_t v = {lo, hi}; bf16x2_t b = __builtin_convertvector(v, bf16x2_t); return __builtin_bit_cast(unsigned, b); }
__device__ __forceinline__ float bflo(unsigned w) { return __builtin_bit_cast(float, w << 16); }
__device__ __forceinline__ float bfhi(unsigned w) { return __builtin_bit_cast(float, w & 0xffff0000u); }
__device__ __forceinline__ float shfl_xor_l(float v, int mask, int lane) { return __builtin_bit_cast(float, __builtin_amdgcn_ds_bpermute((lane ^ mask) << 2, __builtin_bit_cast(int, v))); }
__device__ __forceinline__ float wave_sum(float v, int lane) {
#pragma unroll
    for (int o = 1; o < 64; o <<= 1) v += shfl_xor_l(v, o, lane);
    return v;
}
__device__ __forceinline__ float gelu_tanh(float x) {
    const float e = __builtin_amdgcn_exp2f(x * (-2.3022081985f + -0.1029432392f * x * x));
    return x * __builtin_amdgcn_rcpf(1.0f + e);
}

using pg8::Unit;
struct EpiF {
    static constexpr bool PERM = true, AFTER_DRAIN = false; static constexpr int REPS = 1;
    static __host__ __device__ __forceinline__ int bmap(int r) { return r; }
    static __host__ __device__ __forceinline__ int amap(int r) { return r; }
    bf16* F; const float* scale; bool pool;
    __device__ __forceinline__ void operator()(const f32x4 (&acc)[2][2][4][2], const Unit& u, int wr, int wc, int fr, int fq) const {
        int fr_ = fr, fq_ = fq; asm volatile("" : "+v"(fr_), "+v"(fq_));
        const int row0 = (pool ? (u.pm >> 2) : u.pm) * 256 + wr * 64 + fr_, col0 = u.pn * 256 + wc * 32 + 8 * fq_;
#pragma unroll
        for (int bj = 0; bj < 2; ++bj) {
            f32x4 s0 = {1.f, 1.f, 1.f, 1.f}, s1 = {1.f, 1.f, 1.f, 1.f};
            if (scale) { s0 = *(const f32x4*)(scale + col0 + bj * 128); s1 = *(const f32x4*)(scale + col0 + bj * 128 + 4); }
#pragma unroll
            for (int ai = 0; ai < 2; ++ai)
#pragma unroll
                for (int m = 0; m < 4; ++m) {
                    const f32x4 v0 = acc[ai][bj][m][0] * s0, v1 = acc[ai][bj][m][1] * s1;
                    u32x4 w; w.x = pk2(v0[0], v0[1]); w.y = pk2(v0[2], v0[3]); w.z = pk2(v1[0], v1[1]); w.w = pk2(v1[2], v1[3]);
                    *(u32x4*)(F + (size_t)(row0 + ai * 128 + m * 16) * DM + col0 + bj * 128) = w;
                }
        }
    }
};
struct EpiGU {
    static constexpr bool PERM = true, AFTER_DRAIN = false; static constexpr int REPS = 1;
    static __host__ __device__ __forceinline__ int bmap(int r) { return r; }
    static __host__ __device__ __forceinline__ int amap(int r) { return (r & 64) + 4 * (r & 15) + ((r >> 4) & 3); }
    bf16* H; float* GS; float* US; const float* cw; const float* cb;
    __device__ __forceinline__ void operator()(const f32x4 (&acc)[2][2][4][2], const Unit& u, int wr, int wc, int fr, int fq) const {
        const int colbase = u.pn * 128 + wc * 32 + fq * 8;
        f32x4 cwv[2][4];
#pragma unroll
        for (int n = 0; n < 2; ++n) { const int col = colbase + 4 * n;
            cwv[n][0] = *(const f32x4*)(cw + col); cwv[n][1] = *(const f32x4*)(cw + DFF + col); cwv[n][2] = *(const f32x4*)(cw + 2 * DFF + col); cwv[n][3] = *(const f32x4*)(cb + col); }
        const f32x4 k1 = {-0.1029432392f, -0.1029432392f, -0.1029432392f, -0.1029432392f}, k0 = {-2.3022081985f, -2.3022081985f, -2.3022081985f, -2.3022081985f};
#pragma unroll
        for (int ai = 0; ai < 2; ++ai) {
            const int strip = u.pm * 4 + ai * 2 + wr;
            u32x4 w[4];
#pragma unroll
            for (int n = 0; n < 2; ++n) {
                const int col = colbase + 4 * n;
                f32x4 s2, s3;
#pragma unroll
                for (int j = 0; j < 4; ++j)
                    asm("s_nop 1\n\tv_mov_b32_dpp %0, %2 row_shr:1 row_mask:0xf bank_mask:0xf bound_ctrl:0\n\tv_mov_b32_dpp %1, %3 row_shr:1 row_mask:0xf bank_mask:0xf bound_ctrl:0"
                        : "=&v"(s2[j]), "=&v"(s3[j]) : "v"(acc[ai][0][2][n][j]), "v"(acc[ai][0][3][n][j]));
#pragma unroll
                for (int m = 0; m < 4; ++m) {
                    const f32x4 g = acc[ai][0][m][n], up = acc[ai][1][m][n];
                    const f32x4 p1 = (m == 0) ? s3 : acc[ai][0][m == 0 ? 0 : m - 1][n];
                    const f32x4 p2 = (m == 0) ? s2 : ((m == 1) ? s3 : acc[ai][0][m < 2 ? 0 : m - 2][n]);
                    const f32x4 cv = __builtin_elementwise_fma(cwv[n][2], g, __builtin_elementwise_fma(cwv[n][1], p1, __builtin_elementwise_fma(cwv[n][0], p2, cwv[n][3])));
                    const f32x4 arg = cv * __builtin_elementwise_fma(cv * cv, k1, k0);
                    f32x4 den;
#pragma unroll
                    for (int j = 0; j < 4; ++j) den[j] = __builtin_amdgcn_rcpf(1.0f + __builtin_amdgcn_exp2f(arg[j]));
                    const f32x4 hv = (cv * up) * den;
                    if (n == 0) { w[m].x = pk2(hv[0], hv[1]); w[m].y = pk2(hv[2], hv[3]); } else { w[m].z = pk2(hv[0], hv[1]); w[m].w = pk2(hv[2], hv[3]); }
                    if (m < 2 && fr == 0) { *(f32x4*)(GS + (size_t)(strip * 4 + 2 + m) * DFF + col) = g; *(f32x4*)(US + (size_t)(strip * 2 + m) * DFF + col) = up; }
                    if (m >= 2 && fr == 15) { *(f32x4*)(GS + (size_t)(strip * 4 + (m - 2)) * DFF + col) = g; }
                }
            }
            const int row0 = u.pm * 256 + ai * 128 + wr * 64 + 4 * fr;
#pragma unroll
            for (int m = 0; m < 4; ++m) *(u32x4*)(H + (size_t)(row0 + m) * DFF + colbase) = w[m];
        }
    }
};
struct EpiRope {
    static constexpr bool PERM = true, AFTER_DRAIN = false; static constexpr int REPS = 1;
    static __host__ __device__ __forceinline__ int bmap(int r) { return r; }
    static __host__ __device__ __forceinline__ int amap(int r) { return r; }
    bf16* O; const float* cosT; const float* sinT; float scale;
    __device__ __forceinline__ void operator()(const f32x4 (&acc)[2][2][4][2], const Unit& u, int wr, int wc, int fr, int fq) const {
        const int a4 = 4 * (4 * (wc & 1) + fq);
#pragma unroll
        for (int ai = 0; ai < 2; ++ai)
#pragma unroll
            for (int m = 0; m < 4; ++m) {
                const int tl = u.pm * 256 + ai * 128 + wr * 64 + m * 16 + fr;
                const int b = tl >> 11, t = tl & 2047;
                const f32x4 c4 = *(const f32x4*)(cosT + t * 32 + a4), s4 = *(const f32x4*)(sinT + t * 32 + a4);
#pragma unroll
                for (int bj = 0; bj < 2; ++bj) {
                    const int col = u.pn * 256 + bj * 128 + wc * 32 + fq * 8;
                    const int g = col >> 10, h = (col >> 6) & 15, p0 = col & 63, dsh = 2 * g;
                    const int pos = ((t & ((1 << dsh) - 1)) << (11 - dsh)) + (t >> dsh);
                    const f32x4 x1 = acc[ai][bj][m][0], x2 = acc[ai][bj][m][1];
                    const f32x4 o1 = (x1 * c4 - x2 * s4) * scale, o2 = (x2 * c4 + x1 * s4) * scale;
                    u32x4 w; w.x = pk2(o1[0], o1[1]); w.y = pk2(o1[2], o1[3]); w.z = pk2(o2[0], o2[1]); w.w = pk2(o2[2], o2[3]);
                    *(u32x4*)(O + ((size_t)((g * 16 + b) * 16 + h) * 2048 + pos) * 64 + p0) = w;
                }
            }
    }
};
template <int G> struct EpiVt {
    static constexpr bool PERM = true, AFTER_DRAIN = false; static constexpr int REPS = 1;
    static __host__ __device__ __forceinline__ int bmap(int c) { return G == 0 ? c : (G == 1 ? (4 * (c & 31) + (c >> 5)) : (16 * (c & 7) + (c >> 3))); }
    static __host__ __device__ __forceinline__ int amap(int r) { return r; }
    bf16* V;
    __device__ __forceinline__ void operator()(const f32x4 (&acc)[2][2][4][2], const Unit& u, int wr, int wc, int fr, int fq) const {
        constexpr int L = 2048 >> (2 * G);
        const int b = u.pn >> 3, tis = u.pn & 7;
#pragma unroll
        for (int ai = 0; ai < 2; ++ai)
#pragma unroll
            for (int m = 0; m < 4; ++m) {
                const int vr = u.pm * 256 + ai * 128 + wr * 64 + m * 16 + fr;
                bf16* base = V + (size_t)((G * 16 + b) * 16 + (vr >> 6)) * (2048 * 64) + (size_t)(vr & 63) * L;
#pragma unroll
                for (int bj = 0; bj < 2; ++bj) {
                    int r, mi;
                    if (G == 0) { r = 0; mi = 256 * tis + bj * 128 + wc * 32 + fq * 8; } else if (G == 1) { r = wc; mi = 64 * tis + 32 * bj + fq * 8; } else { r = wc * 4 + fq; mi = 16 * tis + 8 * bj; }
                    const f32x4 v0 = acc[ai][bj][m][0], v1 = acc[ai][bj][m][1];
                    u32x4 w; w.x = pk2(v0[0], v0[1]); w.y = pk2(v0[2], v0[3]); w.z = pk2(v1[0], v1[1]); w.w = pk2(v1[2], v1[3]);
                    *(u32x4*)(base + (size_t)r * 64 * L + mi) = w;
                }
            }
    }
};
struct PoolOrder {
    int G, c, ntiles;
    __device__ bool next(int i, Unit& u) const { const int tile = c + G * (i >> 2); if (tile >= ntiles) return false; u.pm = tile * 4 + (i & 3); u.pn = i & 3; return true; }
    __device__ __forceinline__ void a_ready(const Unit&) const {}
    __device__ __forceinline__ void done(const Unit&) const {}
};

template <class Map>
__device__ __forceinline__ void transpose_w(int K, int N, int ldw, bf16* Wt, const Map& cmap, LAS float* scr, int gw, int ngw, int lane) {
    const int nblk = N / 32, items = (K / 64) * nblk;
    for (int it = gw; it < items; it += ngw) {
        const int kb = it / nblk, nb = it % nblk, k0 = 64 * kb, n0 = 32 * nb;
        const float* src = cmap(n0 + 4 * (lane & 7)) + (size_t)(k0 + (lane >> 3)) * ldw;
        f32x4 tq[8];
#pragma unroll
        for (int i = 0; i < 8; ++i) tq[i] = *(const f32x4*)(src + (size_t)(8 * i) * ldw);
#pragma unroll
        for (int i = 0; i < 8; ++i) { LAS float* d = scr + (8 * i + (lane >> 3)) * 33 + 4 * (lane & 7); d[0] = tq[i][0]; d[1] = tq[i][1]; d[2] = tq[i][2]; d[3] = tq[i][3]; }
        asm volatile("s_waitcnt lgkmcnt(0)" ::: "memory");
        const int c = lane & 7;
#pragma unroll
        for (int j = 0; j < 4; ++j) {
            const int n = (lane >> 3) + 8 * j; const LAS float* s = scr + (8 * c) * 33 + n;
            u32x4 o; o.x = pk2(s[0], s[33]); o.y = pk2(s[2 * 33], s[3 * 33]); o.z = pk2(s[4 * 33], s[5 * 33]); o.w = pk2(s[6 * 33], s[7 * 33]);
            *(u32x4*)(Wt + (size_t)(n0 + n) * K + k0 + 8 * c) = o;
        }
        asm volatile("s_waitcnt lgkmcnt(0)" ::: "memory");
    }
}
struct MapGen { int type; const float* W; const float* W2;
    __device__ __forceinline__ const float* operator()(int n) const {
        if (type == 0) return W + n;
        if (type == 1) { const int p = n & 63; const int dsrc = (p & 4) ? (32 + 4 * (p >> 3) + (p & 3)) : (4 * (p >> 3) + (p & 3)); return W + (n & ~63) + dsrc; }
        const int pn = n >> 8, q = n & 255; return (q < 128) ? (W + pn * 128 + q) : (W2 + pn * 128 + q - 128);
    } };
template <class PT> __device__ __forceinline__ void prep_phase(const PT& p, LAS unsigned char* lds, int gw, int ngw, int lane, int wave) {
    LAS float* scr = (LAS float*)(lds + wave * 16384);
    unsigned char* ws = p.ws;
    for (int mi = 0; mi < 22; ++mi) {
        int K, N, ldw; bf16* Wt; MapGen mp; mp.W2 = nullptr;
        if (mi < 8) { K = 256; N = 256; ldw = 256; Wt = (bf16*)(ws + WS_WPOOL) + (size_t)mi * 65536; mp.type = 0; mp.W = p.pool_w + (size_t)mi * 65536; }
        else if (mi < 12) { const int l = mi - 8; K = DM; N = 2 * DFF; ldw = DFF; Wt = (bf16*)(ws + WS_WGU) + (size_t)l * 2 * DFF * DM; mp.type = 2; mp.W = p.w_gate + (size_t)l * DM * DFF; mp.W2 = p.w_up + (size_t)l * DM * DFF; }
        else if (mi < 16) { const int l = mi - 12; K = DFF; N = DM; ldw = DM; Wt = (bf16*)(ws + WS_WDOWN) + (size_t)l * DM * DFF; mp.type = 0; mp.W = p.w_down + (size_t)l * DFF * DM; }
        else if (mi < 18) { const int j = mi - 16; K = DM; N = QD; ldw = QD; Wt = (bf16*)(ws + WS_WQ) + (size_t)j * QD * DM; mp.type = 1; mp.W = p.w_q + (size_t)j * DM * QD; }
        else if (mi < 20) { const int j = mi - 18; K = DM; N = DM; ldw = DM; Wt = (bf16*)(ws + WS_WO) + (size_t)j * DM * DM; mp.type = 0; mp.W = p.w_o + (size_t)j * DM * DM; }
        else if (mi == 20) { K = DM; N = QD; ldw = 2 * QD; Wt = (bf16*)(ws + WS_WK); mp.type = 1; mp.W = p.w_kv; }
        else { K = DM; N = QD; ldw = 2 * QD; Wt = (bf16*)(ws + WS_WV); mp.type = 0; mp.W = p.w_kv + QD; }
        transpose_w(K, N, ldw, Wt, mp, scr, gw, ngw, lane);
    }
    float* cosT = (float*)(ws + WS_ROPE); float* sinT = cosT + SEQ * 32;
    for (int i = gw * 64 + lane; i < SEQ * 32; i += ngw * 64) {
        const int t = i >> 5, f = i & 31;
        const double rev = (double)t * p.inv_freq[f] * 0.15915494309189535;
        const float fr = (float)(rev - rint(rev));
        cosT[i] = __builtin_amdgcn_cosf(fr); sinT[i] = __builtin_amdgcn_sinf(fr);
    }
}

__device__ __forceinline__ void pool_phase(const float* xin, bf16* PA, int gtid, int nthr) {
    for (int idx = gtid; idx < (MTOK / 32) * 128; idx += nthr) {
        const int run = idx >> 7, rem = idx & 127, g = rem >> 5, ch = rem & 31;
        const int w = 2 << g, ts = run * 32, pos0 = ts & 2047;
        const float* px = xin + (size_t)ts * DM + g * 256 + ch * 8;
        f32x4 s0 = {0.f, 0.f, 0.f, 0.f}, s1 = {0.f, 0.f, 0.f, 0.f};
        const int nb = (pos0 < w) ? pos0 : w;
        for (int j = 1; j <= nb; ++j) { s0 += *(const f32x4*)(px - (size_t)j * DM); s1 += *(const f32x4*)(px - (size_t)j * DM + 4); }
        bf16* po = PA + ((size_t)((ts >> 8) * 4 + g) * 256 + (ts & 255)) * 256 + ch * 8;
#pragma unroll 4
        for (int i = 0; i < 32; ++i) {
            const int pos = pos0 + i;
            const f32x4 x0 = *(const f32x4*)(px + (size_t)i * DM), x1 = *(const f32x4*)(px + (size_t)i * DM + 4);
            s0 += x0; s1 += x1;
            if (pos >= w) { s0 -= *(const f32x4*)(px + (size_t)(i - w) * DM); s1 -= *(const f32x4*)(px + (size_t)(i - w) * DM + 4); }
            const float ic = 1.0f / (float)((pos + 1 < w) ? (pos + 1) : w);
            const f32x4 a0 = s0 * ic - x0, a1 = s1 * ic - x1;
            u32x4 o; o.x = pk2(a0[0], a0[1]); o.y = pk2(a0[2], a0[3]); o.z = pk2(a1[0], a1[1]); o.w = pk2(a1[2], a1[3]);
            *(u32x4*)(po + (size_t)i * 256) = o;
        }
    }
}
__device__ __forceinline__ void wave_sum2(float& a, float& b, int lane) {
    float t, u;
    asm("s_nop 1\n\tv_add_f32_dpp %0, %2, %2 quad_perm:[1,0,3,2] row_mask:0xf bank_mask:0xf\n\tv_add_f32_dpp %1, %3, %3 quad_perm:[1,0,3,2] row_mask:0xf bank_mask:0xf" : "=&v"(t), "=&v"(u) : "v"(a), "v"(b));
    asm("s_nop 1\n\tv_add_f32_dpp %0, %2, %2 quad_perm:[2,3,0,1] row_mask:0xf bank_mask:0xf\n\tv_add_f32_dpp %1, %3, %3 quad_perm:[2,3,0,1] row_mask:0xf bank_mask:0xf" : "=&v"(a), "=&v"(b) : "v"(t), "v"(u));
    asm("s_nop 1\n\tv_add_f32_dpp %0, %2, %2 row_half_mirror row_mask:0xf bank_mask:0xf\n\tv_add_f32_dpp %1, %3, %3 row_half_mirror row_mask:0xf bank_mask:0xf" : "=&v"(t), "=&v"(u) : "v"(a), "v"(b));
    asm("s_nop 1\n\tv_add_f32_dpp %0, %2, %2 row_mirror row_mask:0xf bank_mask:0xf\n\tv_add_f32_dpp %1, %3, %3 row_mirror row_mask:0xf bank_mask:0xf" : "=&v"(a), "=&v"(b) : "v"(t), "v"(u));
    a += shfl_xor_l(a, 16, lane); b += shfl_xor_l(b, 16, lane);
    a += shfl_xor_l(a, 32, lane); b += shfl_xor_l(b, 32, lane);
}
__device__ __forceinline__ float fp8lo(unsigned w, int k) { return k == 0 ? __builtin_amdgcn_cvt_f32_fp8((int)w, 0) : k == 1 ? __builtin_amdgcn_cvt_f32_fp8((int)w, 1) : k == 2 ? __builtin_amdgcn_cvt_f32_fp8((int)w, 2) : __builtin_amdgcn_cvt_f32_fp8((int)w, 3); }
template <bool IN_SPLIT, bool OUT_SPLIT>
__device__ __forceinline__ void addln_phase(const float* base, float* S, const bf16* F, bf16* XB, const float* gB, const float* bB, int nrows, int gw, int ngw, int lane) {
    f32x4 gb[4], bb[4];
#pragma unroll
    for (int j = 0; j < 2; ++j)
#pragma unroll
        for (int h = 0; h < 2; ++h) { gb[2 * j + h] = *(const f32x4*)(gB + 8 * lane + 512 * j + 4 * h); bb[2 * j + h] = *(const f32x4*)(bB + 8 * lane + 512 * j + 4 * h); }
    u32x4 fw[2], hw[2]; u32x2 lw[2]; f32x4 xv[4];
#define ADDLN_LOAD(ROW) do { const size_t ro_ = (size_t)(ROW) * DM + 8 * lane; \
        _Pragma("unroll") for (int j = 0; j < 2; ++j) fw[j] = *(const u32x4*)(F + ro_ + 512 * j); \
        if (IN_SPLIT) { const unsigned char* lo_ = (const unsigned char*)(S + (size_t)(ROW) * DM) + 8 * lane; \
            _Pragma("unroll") for (int j = 0; j < 2; ++j) { hw[j] = *(const u32x4*)(XB + ro_ + 512 * j); lw[j] = *(const u32x2*)(lo_ + 512 * j); } } \
        else { _Pragma("unroll") for (int j = 0; j < 2; ++j) { xv[2 * j] = *(const f32x4*)(base + ro_ + 512 * j); xv[2 * j + 1] = *(const f32x4*)(base + ro_ + 512 * j + 4); } } } while (0)
    if (gw < nrows) ADDLN_LOAD(gw);
    for (int row = gw; row < nrows; row += ngw) {
        const size_t ro = (size_t)row * DM + 8 * lane;
        unsigned char* lo = (unsigned char*)(S + (size_t)row * DM) + 8 * lane;
        f32x4 v[4]; float s = 0.f, q = 0.f;
#pragma unroll
        for (int j = 0; j < 2; ++j)
#pragma unroll
            for (int h = 0; h < 2; ++h) {
                const int c = 2 * j + h;
                if (IN_SPLIT) { const unsigned h0 = hw[j][2 * h], h1 = hw[j][2 * h + 1], l4 = lw[j][h];
                    v[c][0] = bflo(h0) + fp8lo(l4, 0) * (1.0f / 512.0f); v[c][1] = bfhi(h0) + fp8lo(l4, 1) * (1.0f / 512.0f);
                    v[c][2] = bflo(h1) + fp8lo(l4, 2) * (1.0f / 512.0f); v[c][3] = bfhi(h1) + fp8lo(l4, 3) * (1.0f / 512.0f); }
                else v[c] = xv[c];
                const unsigned f0 = fw[j][2 * h], f1 = fw[j][2 * h + 1];
                const f32x4 f = {bflo(f0), bfhi(f0), bflo(f1), bfhi(f1)};
                v[c] = v[c] * ALPHA + f;
                s += (v[c][0] + v[c][1]) + (v[c][2] + v[c][3]);
                q += (v[c][0] * v[c][0] + v[c][1] * v[c][1]) + (v[c][2] * v[c][2] + v[c][3] * v[c][3]);
            }
        const int nrow = row + ngw;
        if (nrow < nrows) ADDLN_LOAD(nrow);
        wave_sum2(s, q, lane);
        const float mean = s * (1.0f / DM);
        const float rstd = 1.0f / sqrtf(fmaxf(q * (1.0f / DM) - mean * mean, 0.f) + LN_EPS);
#pragma unroll
        for (int j = 0; j < 2; ++j) {
            const f32x4 y0 = (v[2 * j] - mean) * rstd * gb[2 * j] + bb[2 * j], y1 = (v[2 * j + 1] - mean) * rstd * gb[2 * j + 1] + bb[2 * j + 1];
            if (OUT_SPLIT) {
                u32x4 w; w.x = pk2(y0[0], y0[1]); w.y = pk2(y0[2], y0[3]); w.z = pk2(y1[0], y1[1]); w.w = pk2(y1[2], y1[3]);
                int l0 = 0, l1 = 0;
                l0 = __builtin_amdgcn_cvt_pk_fp8_f32((y0[0] - bflo(w.x)) * 512.0f, (y0[1] - bfhi(w.x)) * 512.0f, l0, false);
                l0 = __builtin_amdgcn_cvt_pk_fp8_f32((y0[2] - bflo(w.y)) * 512.0f, (y0[3] - bfhi(w.y)) * 512.0f, l0, true);
                l1 = __builtin_amdgcn_cvt_pk_fp8_f32((y1[0] - bflo(w.z)) * 512.0f, (y1[1] - bfhi(w.z)) * 512.0f, l1, false);
                l1 = __builtin_amdgcn_cvt_pk_fp8_f32((y1[2] - bflo(w.w)) * 512.0f, (y1[3] - bfhi(w.w)) * 512.0f, l1, true);
                u32x2 l; l.x = (unsigned)l0; l.y = (unsigned)l1;
                *(u32x4*)(XB + ro + 512 * j) = w; *(u32x2*)(lo + 512 * j) = l;
            } else { *(f32x4*)(S + ro + 512 * j) = y0; *(f32x4*)(S + ro + 512 * j + 4) = y1; }
        }
    }
#undef ADDLN_LOAD
}
__device__ __forceinline__ void fixup_phase(bf16* H, const float* GS, const float* US, const float* cw, const float* cb, int nstrips, int gtid, int nthr) {
    const int total = nstrips * 2 * (DFF / 4);
    for (int idx = gtid; idx < total; idx += nthr) {
        const int cq = idx % (DFF / 4), rest = idx / (DFF / 4), lr = rest & 1, strip = rest >> 1, col = 4 * cq;
        const bool first = ((strip & 31) == 0);
        const f32x4 z = {0.f, 0.f, 0.f, 0.f};
        const f32x4 pm2 = first ? z : *(const f32x4*)(GS + (size_t)((strip - 1) * 4 + 0) * DFF + col);
        const f32x4 pm1 = first ? z : *(const f32x4*)(GS + (size_t)((strip - 1) * 4 + 1) * DFF + col);
        const f32x4 c0 = *(const f32x4*)(GS + (size_t)(strip * 4 + 2) * DFF + col), c1 = *(const f32x4*)(GS + (size_t)(strip * 4 + 3) * DFF + col);
        const f32x4 up = *(const f32x4*)(US + (size_t)(strip * 2 + lr) * DFF + col);
        const f32x4 w0 = *(const f32x4*)(cw + col), w1 = *(const f32x4*)(cw + DFF + col), w2 = *(const f32x4*)(cw + 2 * DFF + col), b4 = *(const f32x4*)(cb + col);
        const f32x4 ga = lr ? pm1 : pm2, gb = lr ? c0 : pm1, gc = lr ? c1 : c0;
        const f32x4 cv = b4 + w0 * ga + w1 * gb + w2 * gc;
        f32x4 hv;
#pragma unroll
        for (int j = 0; j < 4; ++j) hv[j] = gelu_tanh(cv[j]) * up[j];
        u32x2 w; w.x = pk2(hv[0], hv[1]); w.y = pk2(hv[2], hv[3]);
        *(u32x2*)(H + (size_t)(strip * 64 + lr) * DFF + col) = w;
    }
}
__device__ __forceinline__ void attn_block(f32x16& o0, f32x16& o1, float& mrun, float& lrun, const bf16x8 (&bq)[4], const bf16x8 (&kf)[4], const bf16x8 (&vf)[2][2], int kb, int qpos, int hl, int lane) {
    f32x16 s;
#pragma unroll
    for (int i = 0; i < 16; ++i) s[i] = 0.f;
#pragma unroll
    for (int k = 0; k < 4; ++k) s = __builtin_amdgcn_mfma_f32_32x32x16_bf16(kf[k], bq[k], s, 0, 0, 0);
    float mloc = -1e30f;
#pragma unroll
    for (int i = 0; i < 16; ++i) {
        const int kpos = kb + 16 * (i >> 3) + 8 * hl + (i & 7);
        const bool ok = (kpos <= qpos) && (kpos + 128 >= qpos);
        s[i] = ok ? s[i] : -1e30f; mloc = fmaxf(mloc, s[i]);
    }
    mloc = fmaxf(mloc, shfl_xor_l(mloc, 32, lane));
    const float mnew = fmaxf(mrun, mloc), al = __builtin_amdgcn_exp2f(mrun - mnew);
    float ps = 0.f;
#pragma unroll
    for (int i = 0; i < 16; ++i) { s[i] = __builtin_amdgcn_exp2f(s[i] - mnew); ps += s[i]; }
    lrun = lrun * al + ps; mrun = mnew;
#pragma unroll
    for (int i = 0; i < 16; ++i) { o0[i] *= al; o1[i] *= al; }
    u32x4 p0, p1;
    p0.x = pk2(s[0], s[1]); p0.y = pk2(s[2], s[3]); p0.z = pk2(s[4], s[5]); p0.w = pk2(s[6], s[7]);
    p1.x = pk2(s[8], s[9]); p1.y = pk2(s[10], s[11]); p1.z = pk2(s[12], s[13]); p1.w = pk2(s[14], s[15]);
    const bf16x8 pb0 = __builtin_bit_cast(bf16x8, p0), pb1 = __builtin_bit_cast(bf16x8, p1);
    o0 = __builtin_amdgcn_mfma_f32_32x32x16_bf16(vf[0][0], pb0, o0, 0, 0, 0);
    o0 = __builtin_amdgcn_mfma_f32_32x32x16_bf16(vf[0][1], pb1, o0, 0, 0, 0);
    o1 = __builtin_amdgcn_mfma_f32_32x32x16_bf16(vf[1][0], pb0, o1, 0, 0, 0);
    o1 = __builtin_amdgcn_mfma_f32_32x32x16_bf16(vf[1][1], pb1, o1, 0, 0, 0);
}
__device__ __forceinline__ void attn_store(bf16* orow, float* lsep, f32x16& o0, f32x16& o1, float mrun, float lrun, int hl, int lane, bool dry) {
    lrun += shfl_xor_l(lrun, 32, lane);
    const float inv = 1.0f / lrun;
#pragma unroll
    for (int dt = 0; dt < 2; ++dt) {
        const f32x16& o = dt ? o1 : o0;
        u32x2 w[4];
#pragma unroll
        for (int a = 0; a < 4; ++a) { w[a].x = pk2(o[4 * a] * inv, o[4 * a + 1] * inv); w[a].y = pk2(o[4 * a + 2] * inv, o[4 * a + 3] * inv); }
#pragma unroll
        for (int pr = 0; pr < 2; ++pr) {
            const u32x2 snd = hl ? w[2 * pr] : w[2 * pr + 1], own = hl ? w[2 * pr + 1] : w[2 * pr];
            u32x2 rcv;
            rcv.x = (unsigned)__builtin_amdgcn_ds_bpermute((lane ^ 32) << 2, (int)snd.x); rcv.y = (unsigned)__builtin_amdgcn_ds_bpermute((lane ^ 32) << 2, (int)snd.y);
            u32x4 c; if (hl) { c.x = rcv.x; c.y = rcv.y; c.z = own.x; c.w = own.y; } else { c.x = own.x; c.y = own.y; c.z = rcv.x; c.w = rcv.y; }
            if (!dry) *(u32x4*)(orow + 32 * dt + 8 * (2 * pr + hl)) = c;
        }
    }
    if (hl == 0 && !dry) *lsep = mrun + __builtin_amdgcn_logf(lrun);
}
__device__ __forceinline__ void attn_phase(bf16* Qb, const bf16* Kb, const bf16* Vt, float* LSE, int gw, int ngw, int lane, bool dry) {
    const int n = lane & 31, hl = lane >> 5;
    const int kperm = (n & ~12) | ((n & 4) << 1) | ((n & 8) >> 1);
    for (int u = gw; u < 3 * 8192; u += ngw) {
        const int g = u >> 13, v = u & 8191, dsh = 2 * g, L = 2048 >> dsh, ncl = 5 - dsh;
        const int rest = v >> ncl, r = rest & ((1 << dsh) - 1), bh = rest >> dsh;
        const int qc = ((v & ((1 << ncl) - 1)) + (rest >> (11 - ncl))) & ((1 << ncl) - 1);
        const size_t hb = (size_t)(g * 256 + bh) * (2048 * 64);
        bf16* qs = Qb + hb + (size_t)(r * L) * 64;
        const bf16* ks = Kb + hb + (size_t)(r * L) * 64;
        const bf16* vs = Vt + hb + (size_t)r * 64 * L;
        const int q0 = qc * 64, qposA = q0 + n, qposB = q0 + 32 + n;
        bf16x8 bqA[4], bqB[4];
#pragma unroll
        for (int k = 0; k < 4; ++k) { bqA[k] = *(const bf16x8*)(qs + (size_t)qposA * 64 + k * 16 + hl * 8); bqB[k] = *(const bf16x8*)(qs + (size_t)qposB * 64 + k * 16 + hl * 8); }
        f32x16 oA0, oA1, oB0, oB1;
#pragma unroll
        for (int i = 0; i < 16; ++i) { oA0[i] = 0.f; oA1[i] = 0.f; oB0[i] = 0.f; oB1[i] = 0.f; }
        float mA = -1e30f, lA = 0.f, mB = -1e30f, lB = 0.f;
        int kb0 = q0 - 128; if (kb0 < 0) kb0 = 0;
        const int kbl = q0 + 32;
        bf16x8 kf[4], vf[2][2], kfn[4], vfn[2][2];
#pragma unroll
        for (int k = 0; k < 4; ++k) kf[k] = *(const bf16x8*)(ks + (size_t)(kb0 + kperm) * 64 + k * 16 + hl * 8);
#pragma unroll
        for (int dt = 0; dt < 2; ++dt)
#pragma unroll
            for (int c = 0; c < 2; ++c) vf[dt][c] = *(const bf16x8*)(vs + (size_t)(32 * dt + n) * L + kb0 + 16 * c + 8 * hl);
        for (int kb = kb0; kb <= kbl; kb += 32) {
            asm volatile("" :: "v"(kf[0]), "v"(kf[1]), "v"(kf[2]), "v"(kf[3]), "v"(vf[0][0]), "v"(vf[0][1]), "v"(vf[1][0]), "v"(vf[1][1]));
            const int kn = (kb + 32 <= kbl) ? kb + 32 : kb;
#pragma unroll
            for (int k = 0; k < 4; ++k) kfn[k] = *(const bf16x8*)(ks + (size_t)(kn + kperm) * 64 + k * 16 + hl * 8);
#pragma unroll
            for (int dt = 0; dt < 2; ++dt)
#pragma unroll
                for (int c = 0; c < 2; ++c) vfn[dt][c] = *(const bf16x8*)(vs + (size_t)(32 * dt + n) * L + kn + 16 * c + 8 * hl);
            if (kb <= q0) attn_block(oA0, oA1, mA, lA, bqA, kf, vf, kb, qposA, hl, lane);
            if (kb >= q0 - 96) attn_block(oB0, oB1, mB, lB, bqB, kf, vf, kb, qposB, hl, lane);
#pragma unroll
            for (int k = 0; k < 4; ++k) kf[k] = kfn[k];
#pragma unroll
            for (int dt = 0; dt < 2; ++dt)
#pragma unroll
                for (int c = 0; c < 2; ++c) vf[dt][c] = vfn[dt][c];
        }
        float* lp = LSE + (size_t)(g * 256 + bh) * 2048 + r * L;
        attn_store(qs + (size_t)qposA * 64, lp + qposA, oA0, oA1, mA, lA, hl, lane, dry);
        attn_store(qs + (size_t)qposB * 64, lp + qposB, oB0, oB1, mB, lB, hl, lane, dry);
    }
}
__device__ __forceinline__ void combine_phase(const bf16* __restrict__ Ob, const float* __restrict__ LSE, bf16* __restrict__ ATT, int gtid, int nthr) {
    constexpr int NI = 4;
    for (int idx0 = gtid; idx0 < MH * 128; idx0 += NI * nthr) {
        float l[NI][3]; u32x4 ov[NI][3];
#pragma unroll
        for (int k = 0; k < NI; ++k) {
            const int idx = idx0 + k * nthr;
            const int oct = idx & 7, h = (idx >> 3) & 15, tl = idx >> 7, b = (tl >> 11) & 15, t = tl & 2047;
#pragma unroll
            for (int g = 0; g < 3; ++g) {
                const int dsh = 2 * g, pos = ((t & ((1 << dsh) - 1)) << (11 - dsh)) + (t >> dsh);
                const size_t ro = (size_t)((g * 16 + b) * 16 + h) * 2048 + pos;
                l[k][g] = LSE[ro]; ov[k][g] = *(const u32x4*)(Ob + ro * 64 + oct * 8);
            }
        }
#pragma unroll
        for (int k = 0; k < NI; ++k) {
            const int idx = idx0 + k * nthr;
            if (idx >= MH * 128) break;
            const int oct = idx & 7, h = (idx >> 3) & 15, tl = idx >> 7;
            const float mx = fmaxf(l[k][0], fmaxf(l[k][1], l[k][2]));
            float w[3];
#pragma unroll
            for (int g = 0; g < 3; ++g) w[g] = __builtin_amdgcn_exp2f(l[k][g] - mx);
            const float inv = 1.0f / (w[0] + w[1] + w[2]);
            u32x4 o;
#pragma unroll
            for (int e = 0; e < 4; ++e) {
                float lo = 0.f, hi = 0.f;
#pragma unroll
                for (int g = 0; g < 3; ++g) { lo += w[g] * bflo(ov[k][g][e]); hi += w[g] * bfhi(ov[k][g][e]); }
                o[e] = pk2(lo * inv, hi * inv);
            }
            *(u32x4*)(ATT + (size_t)tl * DM + h * 64 + oct * 8) = o;
        }
    }
}

#define XB_TMO      128
#define XB_XCNT(j)  (256  + 64 * (j))
#define XB_XSUB(j)  (1280 + 64 * (j))
#define XB_XGEN(j)  (2304 + 64 * (j))
#define XB_TOP      3328
#define XB_TOPGEN   3392
#define XCD_BAR_WORDS 3456
#define XB_SPIN_CAP (1u << 22)
__device__ __forceinline__ unsigned xb_ld(unsigned* p)              { return __hip_atomic_load(p, __ATOMIC_RELAXED, __HIP_MEMORY_SCOPE_AGENT); }
__device__ __forceinline__ unsigned xb_add(unsigned* p, unsigned v) { return __hip_atomic_fetch_add(p, v, __ATOMIC_RELAXED, __HIP_MEMORY_SCOPE_AGENT); }
__device__ __forceinline__ unsigned xb_xcc_id() { return (unsigned)__builtin_amdgcn_s_getreg((3 << 11) | 20) & 0xFu; }
#define XB_SPIN(cond, bar) do { unsigned _sp = 0; while (cond) { __builtin_amdgcn_s_sleep(1); \
    if ((++_sp & 255u) == 0u) { if (xb_ld(&(bar)[XB_TMO])) break; if (_sp > XB_SPIN_CAP) { atomicAdd(&(bar)[XB_TMO], 1u); break; } } } } while (0)
__device__ __forceinline__ void xcd_barrier_complete(unsigned* bar, unsigned x, unsigned& nloc, unsigned& nx) {
    const unsigned G = gridDim.x * gridDim.y * gridDim.z;
    unsigned sum, cnt, mine, sp = 0u;
    for (;;) {
        sum = 0u; cnt = 0u; mine = 0u;
#pragma unroll
        for (unsigned j = 0; j < 16; ++j) { const unsigned c = xb_ld(&bar[XB_XCNT(j)]); sum += c; cnt += (c > 0u) ? 1u : 0u; mine = (j == x) ? c : mine; }
        if (sum == G) break;
        __builtin_amdgcn_s_sleep(1);
        if ((++sp & 255u) == 0u) { if (xb_ld(&bar[XB_TMO])) break; if (sp > XB_SPIN_CAP) { atomicAdd(&bar[XB_TMO], 1u); break; } }
    }
    nloc = mine > 0u ? mine : 1u; nx = cnt > 0u ? cnt : 1u;
}
__device__ __forceinline__ void xcd_barrier(unsigned* bar, unsigned x, volatile LAS unsigned* st, int tid) {
    asm volatile("s_waitcnt vmcnt(0)" ::: "memory");
    __syncthreads();
    if (tid == 0) {
        __builtin_amdgcn_s_waitcnt(0);
        unsigned nloc = st[0], nx = st[1];
        if (nloc == 0u) { xcd_barrier_complete(bar, x, nloc, nx); st[0] = nloc; st[1] = nx; }
        const unsigned old = xb_add(&bar[XB_XSUB(x)], 1u);
        const unsigned gen = old / nloc;
        if (old + 1u == (gen + 1u) * nloc) {
            __builtin_amdgcn_fence(__ATOMIC_RELEASE, "agent");
            asm volatile("s_waitcnt vmcnt(0)" ::: "memory");
            const unsigned og = xb_add(&bar[XB_TOP], 1u);
            const unsigned tg = og / nx;
            if (og + 1u == (tg + 1u) * nx) xb_add(&bar[XB_TOPGEN], 1u);
            else XB_SPIN(xb_ld(&bar[XB_TOPGEN]) == tg, bar);
            __builtin_amdgcn_fence(__ATOMIC_ACQUIRE, "agent");
            xb_add(&bar[XB_XGEN(x)], 1u);
            asm volatile("s_waitcnt vmcnt(0)" ::: "memory");
        } else {
            XB_SPIN(xb_ld(&bar[XB_XGEN(x)]) == gen, bar);
            __builtin_amdgcn_fence(__ATOMIC_ACQUIRE, "agent");
            asm volatile("s_waitcnt vmcnt(0)" ::: "memory");
        }
    }
    __syncthreads();
}

__device__ __forceinline__ int get_lane() { int l; asm volatile("v_mbcnt_lo_u32_b32 %0, -1, 0\n\tv_mbcnt_hi_u32_b32 %0, -1, %0" : "=&v"(l)); return l; }
enum Kind { K_PREP = 0, K_POOL, K_POOLGEMM, K_LN1, K_GU, K_FIXUP, K_DOWN, K_LN2, K_KV, K_QPROJ, K_ATTN, K_COMBINE, K_OPROJ };
constexpr int NPH = 1 + 14 + 2 * 19;
__global__ void __launch_bounds__(NTHREADS, 2) yoco_fwd(Params p_unused) {
    extern __shared__ __attribute__((aligned(16))) unsigned char lds_raw[];
    LAS unsigned char* lds = (LAS unsigned char*)lds_raw;
    cg::grid_group grid = cg::this_grid();
    typedef const Params __attribute__((address_space(4))) CParams;
    CParams* pp0 = (CParams*)__builtin_amdgcn_kernarg_segment_ptr();
    const int wave0 = __builtin_amdgcn_readfirstlane((int)threadIdx.x >> 6);
    volatile LAS unsigned* bst = (volatile LAS unsigned*)(lds + 131072);
    if (threadIdx.x < 4) bst[threadIdx.x] = 0u;
    __syncthreads();
    unsigned* bar = (unsigned*)(pp0->ws + WS_BAR);
    const unsigned xcc = xb_xcc_id();
    if (threadIdx.x == 0) (void)xb_add(&bar[XB_XCNT(xcc)], 1u);
    grid.sync();
    const int hi = pp0->ph_hi < NPH ? pp0->ph_hi : NPH;
    for (int ph = pp0->ph_lo; ph < hi; ++ph) {
        CParams* pq = pp0; asm volatile("" : "+s"(pq));
        CParams& p = *pq;
        int wave = wave0, bx = blockIdx.x, G = gridDim.x;
        asm volatile("" : "+s"(wave)); asm volatile("" : "+s"(bx)); asm volatile("" : "+s"(G));
        const int gw = bx * NWAVES + wave, ngw = G * NWAVES, nthr = G * NTHREADS;
#define LT const int lane = get_lane(), tid = wave * 64 + lane, gtid = bx * NTHREADS + tid; (void)lane; (void)tid; (void)gtid;
        int kind, layer = 0, half = 0; bool full = true;
        if (ph == 0) kind = K_PREP;
        else if (ph < 15) { layer = (ph - 1) / 7; kind = K_POOL + (ph - 1) % 7; }
        else {
            const int q = ph - 15, r = q % 19; half = q / 19; full = false;
            if (r == 0) kind = K_KV;
            else { const int k = (r - 1) % 9; layer = 2 + (r - 1) / 9; kind = k == 0 ? K_QPROJ : k == 1 ? K_ATTN : k == 2 ? K_COMBINE : k == 3 ? K_OPROJ : k == 4 ? K_LN1 : k == 5 ? K_GU : k == 6 ? K_FIXUP : k == 7 ? K_DOWN : K_LN2; }
        }
        unsigned char* ws = p.ws;
        const int nrows = full ? MTOK : MH; const size_t roff = full ? 0 : (size_t)half * MH;
        float* Sh = p.out + roff * DM; bf16* XBh = (bf16*)(ws + WS_XB) + roff * DM;
        bf16* HB = (bf16*)(ws + WS_H);
        switch (kind) {
        case K_PREP: { LT prep_phase(p, lds, gw, ngw, lane, wave); } break;
        case K_POOL: { LT pool_phase(layer == 0 ? p.x : p.out, HB, gtid, nthr); } break;
        case K_POOLGEMM: { LT
            pg8::Gemm g{HB, (const bf16*)(ws + WS_WPOOL) + (size_t)layer * 4 * 65536, MTOK * 4, 1024, 256};
            PoolOrder O{G, bx, MTOK / 256}; EpiF E{(bf16*)(ws + WS_FA), p.pool_scale + layer * DM, true};
            pg8::gemm_phase<EpiF, PoolOrder, true, true>(lds, g, O, E, tid);
        } break;
        case K_LN1: { LT
            if (full) addln_phase<false, true>(layer == 0 ? p.x : p.out, Sh, (const bf16*)(ws + WS_FA), XBh, p.ln1_g + layer * DM, p.ln1_b + layer * DM, nrows, gw, ngw, lane);
            else addln_phase<true, true>(Sh, Sh, (const bf16*)(ws + WS_H), XBh, p.ln1_g + layer * DM, p.ln1_b + layer * DM, nrows, gw, ngw, lane);
        } break;
        case K_LN2: { LT
            const bf16* Fp = full ? (const bf16*)(ws + WS_FA) : (const bf16*)(ws + WS_ATT);
            if (layer == 0 || layer == 3) addln_phase<true, false>(Sh, Sh, Fp, XBh, p.ln2_g + layer * DM, p.ln2_b + layer * DM, nrows, gw, ngw, lane);
            else addln_phase<true, true>(Sh, Sh, Fp, XBh, p.ln2_g + layer * DM, p.ln2_b + layer * DM, nrows, gw, ngw, lane);
        } break;
        case K_GU: { LT
            pg8::Gemm g{XBh, (const bf16*)(ws + WS_WGU) + (size_t)layer * 2 * DFF * DM, nrows, 2 * DFF, DM};
            pg8::StaticOrder O; O.init(nrows, 2 * DFF, G, bx);
            EpiGU E{HB, (float*)(ws + WS_GS), (float*)(ws + WS_US), p.conv_w + (size_t)layer * 3 * DFF, p.conv_b + (size_t)layer * DFF};
            pg8::gemm_phase<EpiGU, pg8::StaticOrder, true, true>(lds, g, O, E, tid);
        } break;
        case K_FIXUP: { LT fixup_phase(HB, (const float*)(ws + WS_GS), (const float*)(ws + WS_US), p.conv_w + (size_t)layer * 3 * DFF, p.conv_b + (size_t)layer * DFF, nrows / 64, gtid, nthr); } break;
        case K_DOWN: case K_OPROJ: { LT
            const bool dn = (kind == K_DOWN);
            pg8::Gemm g{dn ? (const bf16*)HB : (const bf16*)(ws + WS_ATT), dn ? (const bf16*)(ws + WS_WDOWN) + (size_t)layer * DM * DFF : (const bf16*)(ws + WS_WO) + (size_t)(layer - 2) * DM * DM, nrows, DM, dn ? DFF : DM};
            pg8::StaticOrder O; O.init(nrows, DM, G, bx);
            EpiF E{dn ? (full ? (bf16*)(ws + WS_FA) : (bf16*)(ws + WS_ATT)) : HB, nullptr, false};
            pg8::gemm_phase<EpiF, pg8::StaticOrder, true, true>(lds, g, O, E, tid);
        } break;
        case K_KV: case K_QPROJ: { LT
            const bool isq = (kind == K_QPROJ);
            const float* cosT = (const float*)(ws + WS_ROPE);
            pg8::Gemm g{XBh, isq ? (const bf16*)(ws + WS_WQ) + (size_t)(layer - 2) * QD * DM : (const bf16*)(ws + WS_WK), MH, QD, DM};
            pg8::StaticOrder O; O.init(MH, QD, G, bx); EpiRope E{isq ? HB : (bf16*)(ws + WS_K), cosT, cosT + SEQ * 32, isq ? QSCALE : 1.0f};
            pg8::gemm_phase<EpiRope, pg8::StaticOrder, true, true>(lds, g, O, E, tid);
            if (!isq) {
                bf16* VB = (bf16*)(ws + WS_V);
                pg8::StaticOrder OV; OV.init(DM, MH, G, bx);
                { pg8::Gemm gv{(const bf16*)(ws + WS_WV), XBh, DM, MH, DM}; EpiVt<0> EV{VB}; pg8::gemm_phase<EpiVt<0>, pg8::StaticOrder, true, true>(lds, gv, OV, EV, tid); }
                { pg8::Gemm gv{(const bf16*)(ws + WS_WV) + (size_t)DM * DM, XBh, DM, MH, DM}; EpiVt<1> EV{VB}; pg8::gemm_phase<EpiVt<1>, pg8::StaticOrder, true, true>(lds, gv, OV, EV, tid); }
                { pg8::Gemm gv{(const bf16*)(ws + WS_WV) + (size_t)2 * DM * DM, XBh, DM, MH, DM}; EpiVt<2> EV{VB}; pg8::gemm_phase<EpiVt<2>, pg8::StaticOrder, true, true>(lds, gv, OV, EV, tid); }
            }
        } break;
        case K_ATTN: { LT
            const int vb = ((G & 7) == 0) ? (bx & 7) * (G >> 3) + (bx >> 3) : bx;
            attn_phase(HB, (const bf16*)(ws + WS_K), (const bf16*)(ws + WS_V), (float*)(ws + WS_LSE), vb * NWAVES + wave, ngw, lane, false); } break;
        case K_COMBINE: { LT combine_phase(HB, (const float*)(ws + WS_LSE), (bf16*)(ws + WS_ATT), gtid, nthr); } break;
        default: break;
        }
        const bool nosync = (kind == K_PREP || kind == K_KV);
        if (ph + 1 < hi && !nosync) xcd_barrier(bar, xcc, bst, wave * 64 + get_lane());
#undef LT
    }
}

extern "C" void kernel_launch(void* const* d_in, const int* in_sizes, int n_in, void* d_out, int out_size, void* d_ws, size_t ws_size, hipStream_t stream) {
    static int grid = 0;
    if (grid == 0) {
        if (n_in != 15 || out_size != MTOK * DM || ws_size < WS_END) { fprintf(stderr, "kernel_launch: unexpected shapes (n_in %d, out %d, ws %zu)\n", n_in, out_size, ws_size); grid = -1; return; }
        int dev = 0, cus = 0, per_cu = 0;
        hipGetDevice(&dev);
        hipDeviceGetAttribute(&cus, hipDeviceAttributeMultiprocessorCount, dev);
        if (hipFuncSetAttribute((const void*)yoco_fwd, hipFuncAttributeMaxDynamicSharedMemorySize, LDS_BYTES) != hipSuccess) { fprintf(stderr, "kernel_launch: hipFuncSetAttribute failed\n"); grid = -1; return; }
        hipOccupancyMaxActiveBlocksPerMultiprocessor(&per_cu, (const void*)yoco_fwd, NTHREADS, LDS_BYTES);
        (void)hipGetLastError();
        if (per_cu < 1) fprintf(stderr, "kernel_launch: occupancy query reports %d blocks per CU\n", per_cu);
        grid = cus > 0 ? cus : 256;
    }
    if (grid < 0) return;
    Params p{};
    p.x = (const float*)d_in[0]; p.pool_w = (const float*)d_in[1]; p.pool_scale = (const float*)d_in[2]; p.w_q = (const float*)d_in[3]; p.w_kv = (const float*)d_in[4];
    p.w_o = (const float*)d_in[5]; p.w_gate = (const float*)d_in[6]; p.w_up = (const float*)d_in[7]; p.conv_w = (const float*)d_in[8]; p.conv_b = (const float*)d_in[9];
    p.w_down = (const float*)d_in[10]; p.ln1_g = (const float*)d_in[11]; p.ln1_b = (const float*)d_in[12]; p.ln2_g = (const float*)d_in[13]; p.ln2_b = (const float*)d_in[14];
    p.out = (float*)d_out; p.ws = (unsigned char*)d_ws;
    for (int i = 0; i < 32; ++i) p.inv_freq[i] = pow(10000.0, -(double)(2 * i) / 64.0);
    p.ph_lo = 0; p.ph_hi = 1000;
    if (hipMemsetAsync((unsigned char*)d_ws + WS_BAR, 0, XCD_BAR_WORDS * 4, stream) != hipSuccess) { fprintf(stderr, "kernel_launch: memset of the barrier words failed\n"); return; }
    void* args[] = {&p};
    hipError_t e = hipLaunchCooperativeKernel((const void*)yoco_fwd, dim3(grid), dim3(NTHREADS), args, LDS_BYTES, stream);
    if (e != hipSuccess) fprintf(stderr, "kernel_launch: cooperative launch failed: %s (grid %d)\n", hipGetErrorString(e), grid);
}
```
